# Optimizing an MI355X kernel written in HIP

```python
import jax, jax.numpy as jnp
from jax import lax
import numpy as np

D_MODEL = 4096
BATCH = 4
SEQ = 2048
DEPTH = 1

MEM_LEN = 256
HEAD_DIM = 128
DIL_GROUPS = ((128, 1), (512, 4), (2048, 16))
ATTN_WIDTH = 3 * D_MODEL // 8
CONV_WIDTH = 3 * D_MODEL // 8
XATTN_WIDTH = D_MODEL // 4
MIX_WIDTH = ATTN_WIDTH + CONV_WIDTH + XATTN_WIDTH
N_ATTN_HEADS = ATTN_WIDTH // HEAD_DIM
HEADS_PER_DIL = N_ATTN_HEADS // len(DIL_GROUPS)
N_XATTN_HEADS = 4
XATTN_HEAD_DIM = XATTN_WIDTH // N_XATTN_HEADS
CONV_K = 3
IN_COLS = 4 * ATTN_WIDTH + 4 * CONV_WIDTH + 2 * XATTN_WIDTH
BLOCK = 128
ROPE_THETA = 10000.0
EPS = 1e-6
NEG_INF = -1e30

kernel_name = "hybrid_dilated_conv_memory_layer"


def rms_norm(x, g):
    x32 = x.astype(jnp.float32)
    y = x32 * lax.rsqrt(jnp.mean(x32 * x32, axis=-1, keepdims=True) + EPS)
    return (y * g.astype(jnp.float32)).astype(x.dtype)


def rope(x, pos):
    half = x.shape[-1] // 2
    inv = 1.0 / (ROPE_THETA ** (jnp.arange(half, dtype=jnp.float32) / half))
    ang = pos.astype(jnp.float32)[:, None] * inv[None, :]
    cos = jnp.cos(ang)[:, None, :]
    sin = jnp.sin(ang)[:, None, :]
    x32 = x.astype(jnp.float32)
    x1, x2 = x32[..., :half], x32[..., half:]
    return jnp.concatenate([x1 * cos - x2 * sin, x2 * cos + x1 * sin], axis=-1).astype(x.dtype)


def dilated_window_attention(q, k, v, window, dilation):
    b, s, h, dh = q.shape
    steps = window // dilation
    L = s // dilation
    nb = -(-L // BLOCK)
    Lp = nb * BLOCK
    bd = b * dilation

    def to_sub(t):
        t = t.reshape(b, L, dilation, h, dh).transpose(0, 2, 1, 3, 4).reshape(bd, L, h, dh)
        return jnp.pad(t, ((0, 0), (0, Lp - L), (0, 0), (0, 0)))

    def band(t):
        tp = jnp.pad(t, ((0, 0), (BLOCK, 0), (0, 0), (0, 0))).reshape(bd, nb + 1, BLOCK, h, dh)
        return jnp.concatenate([tp[:, :-1], tp[:, 1:]], axis=2)

    qb = to_sub(q).reshape(bd, nb, BLOCK, h, dh)
    kb = band(to_sub(k))
    vb = band(to_sub(v))
    scores = jnp.einsum('znqhd,znkhd->znhqk', qb, kb,
                        preferred_element_type=jnp.float32) * (dh ** -0.5)
    qi = jnp.arange(BLOCK)[:, None]
    kk = jnp.arange(2 * BLOCK)[None, :]
    dist = qi + BLOCK - kk
    key_pos = (jnp.arange(nb)[:, None, None] - 1) * BLOCK + kk[None]
    valid = (dist >= 0) & (dist <= steps) & (key_pos >= 0)
    scores = jnp.where(valid[None, :, None], scores, NEG_INF)
    lse = jax.nn.logsumexp(scores, axis=-1)
    p = jnp.exp(scores - lse[..., None])
    out = jnp.einsum('znhqk,znkhd->znqhd', p.astype(v.dtype), vb)
    out = out.reshape(b, dilation, Lp, h, dh)[:, :, :L].transpose(0, 2, 1, 3, 4).reshape(b, s, h, dh)
    lse = lse.transpose(0, 1, 3, 2).reshape(b, dilation, Lp, h)[:, :, :L]
    lse = lse.transpose(0, 2, 1, 3).reshape(b, s, h)
    return out, lse


def short_conv(u, w):
    s = u.shape[1]
    up = jnp.pad(u, ((0, 0), (CONV_K - 1, 0), (0, 0)))
    y = up[:, 0:s] * w[0]
    for j in range(1, CONV_K):
        y = y + up[:, j:j + s] * w[j]
    return y


def memory_cross_attention(q, mk, mv):
    scores = jnp.einsum('bshd,bmhd->bhsm', q, mk,
                        preferred_element_type=jnp.float32) * (q.shape[-1] ** -0.5)
    p = jax.nn.softmax(scores, axis=-1)
    return jnp.einsum('bhsm,bmhd->bshd', p.astype(mv.dtype), mv)


def setup_inputs(seed: int = 0) -> dict:
    key = jax.random.key(seed)
    ks = jax.random.split(key, 10)
    f32 = jnp.float32
    x = jax.random.normal(ks[0], (BATCH, SEQ, D_MODEL), f32)
    mem = jax.random.normal(ks[1], (BATCH, MEM_LEN, D_MODEL), f32)
    pre_norm = 1.0 + 0.05 * jax.random.normal(ks[2], (DEPTH, D_MODEL), f32)
    w_in = jax.random.normal(ks[3], (DEPTH, D_MODEL, IN_COLS), f32) * D_MODEL ** -0.5
    conv_w = jax.random.normal(ks[4], (DEPTH, CONV_K, CONV_WIDTH), f32) * CONV_K ** -0.5
    mem_norm = 1.0 + 0.05 * jax.random.normal(ks[5], (DEPTH, D_MODEL), f32)
    w_mem_kv = jax.random.normal(ks[6], (DEPTH, D_MODEL, 2 * XATTN_WIDTH), f32) * D_MODEL ** -0.5
    w_out = jax.random.normal(ks[7], (DEPTH, MIX_WIDTH, D_MODEL), f32) * MIX_WIDTH ** -0.5
    post_norm = 1.0 + 0.05 * jax.random.normal(ks[8], (DEPTH, D_MODEL), f32)
    return {"x": x, "mem": mem, "pre_norm": pre_norm, "w_in": w_in, "conv_w": conv_w,
            "mem_norm": mem_norm, "w_mem_kv": w_mem_kv, "w_out": w_out,
            "post_norm": post_norm}


def reference(x, mem, pre_norm, w_in, conv_w, mem_norm, w_mem_kv, w_out, post_norm):
    b, s, _ = x.shape
    m_len = mem.shape[1]
    pos = jnp.arange(s)
    mem_pos = jnp.arange(m_len)
    sizes = (ATTN_WIDTH,) * 4 + (CONV_WIDTH,) * 4 + (XATTN_WIDTH,) * 2
    split_pts = [int(c) for c in np.cumsum(sizes)[:-1]]
    for layer in range(DEPTH):
        h = rms_norm(x, pre_norm[layer])
        proj = h @ w_in[layer]
        q_a, k_a, v_a, z_a, u_c, b_c, c_c, z_c, q_x, z_x = jnp.split(proj, split_pts, axis=-1)

        q_a = rope(q_a.reshape(b, s, N_ATTN_HEADS, HEAD_DIM), pos)
        k_a = rope(k_a.reshape(b, s, N_ATTN_HEADS, HEAD_DIM), pos)
        v_a = v_a.reshape(b, s, N_ATTN_HEADS, HEAD_DIM)
        outs, lses = [], []
        for g, (window, dil) in enumerate(DIL_GROUPS):
            sl = slice(g * HEADS_PER_DIL, (g + 1) * HEADS_PER_DIL)
            o, l = dilated_window_attention(q_a[:, :, sl], k_a[:, :, sl], v_a[:, :, sl], window, dil)
            outs.append(o)
            lses.append(l)
        o = jnp.stack(outs, axis=2)
        alpha = jax.nn.softmax(jnp.stack(lses, axis=2), axis=2)
        y_attn = (o * alpha[..., None].astype(o.dtype)).reshape(b, s, ATTN_WIDTH)
        y_attn = y_attn * jax.nn.silu(z_a)

        y_conv = b_c * short_conv(c_c * u_c, conv_w[layer]) * jax.nn.silu(z_c)

        mkv = rms_norm(mem, mem_norm[layer]) @ w_mem_kv[layer]
        mk, mv = jnp.split(mkv, 2, axis=-1)
        mk = rope(mk.reshape(b, m_len, N_XATTN_HEADS, XATTN_HEAD_DIM), mem_pos)
        mv = mv.reshape(b, m_len, N_XATTN_HEADS, XATTN_HEAD_DIM)
        qx = rope(q_x.reshape(b, s, N_XATTN_HEADS, XATTN_HEAD_DIM), pos + m_len)
        y_x = memory_cross_attention(qx, mk, mv).reshape(b, s, XATTN_WIDTH) * jax.nn.silu(z_x)

        y = jnp.concatenate([y_attn, y_conv, y_x], axis=-1) @ w_out[layer]
        x = x + rms_norm(y, post_norm[layer])
    return x
```

```cpp
#include <hip/hip_runtime.h>
#include <hip/hip_cooperative_groups.h>
#include <cstdio>
#include <cstdint>
namespace cg = cooperative_groups;

#ifndef N_LAUNCH_MODE
#define N_LAUNCH_MODE 1
#endif

#ifndef FUSED_OUT
#define FUSED_OUT 1
#endif
#define LAS __attribute__((address_space(3)))
typedef unsigned short bf16_t;
typedef short bf16x8 __attribute__((ext_vector_type(8)));
typedef short s16x4 __attribute__((ext_vector_type(4)));
typedef float f32x4 __attribute__((ext_vector_type(4)));
typedef unsigned u32x4 __attribute__((ext_vector_type(4)));
typedef unsigned u32x2 __attribute__((ext_vector_type(2)));

constexpr int SEQ = 2048, BATCH = 4, M = BATCH * SEQ, D = 4096, NIN = 14336, MEML = 256, MM = BATCH * MEML;
constexpr int QA = 0, KA = 1536, VA = 3072, ZA = 4608, UC = 6144, BC = 7680, CC = 9216, ZC = 10752, QX = 12288, ZX = 13312;
constexpr int NKV = 2048, KSPLIT = 8;
constexpr float EPS = 1e-6f;
constexpr float LOG2E = 1.4426950408889634f, LN2 = 0.6931471805599453f;

constexpr size_t MiB = 1u << 20;
constexpr size_t WS_WIN = 0;
constexpr size_t WS_WOUT = 112 * MiB;
constexpr size_t WS_WMEM = 144 * MiB;
constexpr size_t WS_H = 160 * MiB;
constexpr size_t WS_MEMN = 224 * MiB;
constexpr size_t WS_PROJ = 232 * MiB;
constexpr size_t WS_MK = 520 * MiB;
constexpr size_t WS_MV = 522 * MiB;
constexpr size_t WS_OA = 524 * MiB;
constexpr size_t WS_LSE = 548 * MiB;
constexpr size_t WS_Y = 549 * MiB;
constexpr size_t WS_Y2 = 613 * MiB;
constexpr size_t WS_SSQ = 741 * MiB;
constexpr size_t WS_C128 = 743 * MiB;
constexpr size_t WS_S128 = WS_C128 + 2048 * 64 * 4;
constexpr size_t WS_C256 = 744 * MiB;
constexpr size_t WS_S256 = WS_C256 + 2304 * 128 * 4;
constexpr size_t WS_BAR = 747 * MiB;
constexpr size_t WS_END = 748 * MiB;

constexpr int LDS_BYTES = 147456;
constexpr int MISC_OFF = LDS_BYTES - 64;

__device__ __forceinline__ unsigned cvt_pk(float lo, float hi) { unsigned r; asm("v_cvt_pk_bf16_f32 %0, %1, %2" : "=v"(r) : "v"(lo), "v"(hi)); return r; }
__device__ __forceinline__ float bf_lo(unsigned u) { return __uint_as_float(u << 16); }
__device__ __forceinline__ float bf_hi(unsigned u) { return __uint_as_float(u & 0xffff0000u); }
__device__ __forceinline__ float silu_f(float z) { return z / (1.0f + __expf(-z)); }
__device__ __forceinline__ float wave_sum(float v) {
#pragma unroll
    for (int o = 1; o < 64; o <<= 1) v += __shfl_xor(v, o);
    return v;
}

namespace pg8 {
constexpr int BM = 256, BK = 64, HALF = 128, HTB = HALF * BK * 2, STAGE_BYTES = 8 * HTB, NXCD = 8, WGM = 4;
__host__ __device__ __forceinline__ int lds_byte(int r, int c) { const int st = (r >> 4) * 2 + (c >> 5), rr = r & 15, cc = c & 31, ob = rr * 64 + cc * 2; return st * 1024 + (ob ^ (((ob >> 9) & 1) << 5)); }
__host__ __device__ __forceinline__ void stage_rc(int b, int& R, int& C) { const int st = b / 1024, sb = b % 1024, swz = sb ^ (((sb >> 9) & 1) << 5); R = (st >> 1) * 16 + swz / 64; C = (st & 1) * 32 + (swz % 64) / 2; }
__host__ __device__ __forceinline__ int perm32(int rho) { const int n = rho >> 4, i = rho & 15; return 8 * (i >> 2) + 4 * n + (i & 3); }
__host__ __device__ __forceinline__ int perm_rope(int R) { const int wc = R >> 5, n = (R >> 4) & 1, i = R & 15; return 64 * n + 16 * wc + i; }

__host__ __device__ __forceinline__ int perm_wide(int R, int h) { const int wc = R >> 5, n = (R >> 4) & 1, fq = (R >> 2) & 3, j = R & 3; return 128 * (wc >> 1) + 64 * h + 32 * (wc & 1) + 8 * fq + 4 * n + j; }

struct Unit { int pm, pn, ks; };
struct Gemm { const bf16_t* A; const bf16_t* Bt; int ld; int kloop; };

struct StaticOrder {
    int nM, nN, nwg, G, c;
    __host__ __device__ void init(int M_, int N_, int G_, int c_) { nM = M_ / BM; nN = N_ / BM; nwg = nM * nN; G = G_; c = c_; }
    __host__ __device__ bool next(int i, Unit& u) const {
        const long L = (long)i * G + c; if (L >= nwg) return false;
        int wgid = (int)L; { const int q = nwg / NXCD, r = nwg % NXCD, xcd = wgid % NXCD, off = wgid / NXCD; wgid = (xcd < r ? xcd * (q + 1) : r * (q + 1) + (xcd - r) * q) + off; }
        const int nig = WGM * nN, gid = wgid / nig, fm = gid * WGM, gsz = (nM - fm) < WGM ? (nM - fm) : WGM;
        u.pm = fm + ((wgid % nig) % gsz); u.pn = (wgid % nig) / gsz; u.ks = 0; return true;
    }
};
struct MemOrder {
    int nd, di;
    __host__ __device__ bool next(int i, Unit& u) const { const int L = i * nd + di; if (di < 0 || L >= 32) return false; u.pm = L & 3; u.pn = L >> 2; u.ks = 0; return true; }
};

struct EpiProj {
    static constexpr int PERM = 3;
    bf16_t* O; const float *c128, *s128;
    static __device__ __forceinline__ void st16(bf16_t* p, const f32x4 a, const f32x4 b) { u32x4 w; w.x = cvt_pk(a[0], a[1]); w.y = cvt_pk(a[2], a[3]); w.z = cvt_pk(b[0], b[1]); w.w = cvt_pk(b[2], b[3]); *(u32x4*)p = w; }
    __device__ __forceinline__ void operator()(const f32x4 (&acc)[2][2][4][2], const Unit& u, int wr, int wc, int fr, int fq) const {
        const int pn = u.pn; const bool rope = (pn < 12), conv = (pn >= 24 && pn < 48);
        const int row0 = u.pm * BM + wr * 64 + fr, dh0 = 32 * (wc & 1) + 8 * fq;
        bf16_t* base = O + (size_t)row0 * NIN + pn * BM + 128 * (wc >> 1) + dh0;
#pragma unroll
        for (int ai = 0; ai < 2; ++ai)
#pragma unroll
            for (int m = 0; m < 4; ++m) { bf16_t* rowp = base + (size_t)(ai * HALF + m * 16) * NIN;
                if (rope) { const int pos = (row0 + ai * HALF + m * 16) & (SEQ - 1); const float* cp = c128 + pos * 64 + dh0; const float* sp = s128 + pos * 64 + dh0;
                    const f32x4 c0 = *(const f32x4*)cp, c1 = *(const f32x4*)(cp + 4), s0 = *(const f32x4*)sp, s1 = *(const f32x4*)(sp + 4);
                    const f32x4 a0 = acc[ai][0][m][0], a1 = acc[ai][0][m][1], b0 = acc[ai][1][m][0], b1 = acc[ai][1][m][1];
                    st16(rowp, a0 * c0 - b0 * s0, a1 * c1 - b1 * s1); st16(rowp + 64, b0 * c0 + a0 * s0, b1 * c1 + a1 * s1);
                } else if (conv) {
                    const f32x4 a0 = acc[ai][0][m][0], a1 = acc[ai][0][m][1], b0 = acc[ai][1][m][0], b1 = acc[ai][1][m][1]; f32x4 r0, r1;
                    if (wc < 2) { r0 = a0 * b0; r1 = a1 * b1; }
                    else {
#pragma unroll
                        for (int e = 0; e < 4; ++e) { r0[e] = a0[e] * silu_f(b0[e]); r1[e] = a1[e] * silu_f(b1[e]); } }
                    st16(O + (size_t)(row0 + ai * HALF + m * 16) * NIN + ((wc < 2) ? UC : BC) + (pn - 24) * 64 + dh0, r0, r1);
                } else { st16(rowp, acc[ai][0][m][0], acc[ai][0][m][1]); st16(rowp + 64, acc[ai][1][m][0], acc[ai][1][m][1]); } }
    }
};
struct EpiMem {
    static constexpr int PERM = 1;
    bf16_t* MKo; bf16_t* MVo;
    static __device__ __forceinline__ void st16(bf16_t* p, const f32x4 a, const f32x4 b) { u32x4 w; w.x = cvt_pk(a[0], a[1]); w.y = cvt_pk(a[2], a[3]); w.z = cvt_pk(b[0], b[1]); w.w = cvt_pk(b[2], b[3]); *(u32x4*)p = w; }
    __device__ __forceinline__ void operator()(const f32x4 (&acc)[2][2][4][2], const Unit& u, int wr, int wc, int fr, int fq) const {
        const int row0 = u.pm * BM + wr * 64 + fr, dh0 = 32 * wc + 8 * fq;
        bf16_t* base = ((u.pn < 4) ? MKo + u.pn * 256 : MVo + (u.pn - 4) * 256) + (size_t)row0 * 1024 + dh0;
#pragma unroll
        for (int ai = 0; ai < 2; ++ai)
#pragma unroll
            for (int m = 0; m < 4; ++m) { bf16_t* rowp = base + (size_t)(ai * HALF + m * 16) * 1024; st16(rowp, acc[ai][0][m][0], acc[ai][0][m][1]); st16(rowp + HALF, acc[ai][1][m][0], acc[ai][1][m][1]); }
    }
};
struct EpiY2 {
    static constexpr int PERM = 0;
    float* O; float* ssq;
    __device__ __forceinline__ void operator()(const f32x4 (&acc)[2][2][4][2], const Unit& u, int wr, int wc, int fr, int fq) const {
        const int row0 = u.pm * BM + wr * 64 + fr, col0 = u.pn * BM + wc * 32 + 4 * fq;
#pragma unroll
        for (int ai = 0; ai < 2; ++ai)
#pragma unroll
            for (int m = 0; m < 4; ++m) { const int row = row0 + ai * HALF + m * 16; float* rowp = O + (size_t)row * D + col0; float s = 0.f;
#pragma unroll
                for (int bj = 0; bj < 2; ++bj)
#pragma unroll
                    for (int n = 0; n < 2; ++n) { const f32x4 v = acc[ai][bj][m][n]; *(f32x4*)(rowp + bj * HALF + 16 * n) = v; s += (v[0] * v[0] + v[1] * v[1]) + (v[2] * v[2] + v[3] * v[3]); }
                s += __shfl_xor(s, 16); s += __shfl_xor(s, 32);
                if (fq == 0) ssq[(size_t)row * 64 + u.pn * 4 + wc] = s; }
    }
};

struct EpiOut {
    static constexpr int PERM = 0;
    const float* x; const float* gain; float* out; float* ssqt; unsigned* cnt;
    __device__ __forceinline__ void operator()(const f32x4 (&acc)[2][2][4][2], const Unit& u, int wr, int wc, int fr, int fq) const {
        const int row0 = u.pm * BM + wr * 64 + fr, col0 = u.pn * BM + wc * 32 + 4 * fq;
#pragma unroll
        for (int ai = 0; ai < 2; ++ai)
#pragma unroll
            for (int m = 0; m < 4; ++m) { const int row = row0 + ai * HALF + m * 16; float s = 0.f;
#pragma unroll
                for (int bj = 0; bj < 2; ++bj)
#pragma unroll
                    for (int n = 0; n < 2; ++n) { const f32x4 v = acc[ai][bj][m][n]; s += (v[0] * v[0] + v[1] * v[1]) + (v[2] * v[2] + v[3] * v[3]); }
                s += __shfl_xor(s, 16); s += __shfl_xor(s, 32);
                if (fq == 0) (void)__hip_atomic_fetch_add(ssqt + row, s, __ATOMIC_RELAXED, __HIP_MEMORY_SCOPE_AGENT); }
        f32x4 gg[2][2];
#pragma unroll
        for (int bj = 0; bj < 2; ++bj)
#pragma unroll
            for (int n = 0; n < 2; ++n) gg[bj][n] = *(const f32x4*)(gain + col0 + bj * HALF + 16 * n);
        f32x4 xv[2][2][2];
#pragma unroll
        for (int g = 0; g < 2; ++g) { const float* xr = x + (size_t)(row0 + g * 16) * D + col0;
#pragma unroll
            for (int bj = 0; bj < 2; ++bj)
#pragma unroll
                for (int n = 0; n < 2; ++n) xv[g][bj][n] = __builtin_nontemporal_load((const f32x4*)(xr + bj * HALF + 16 * n)); }
        asm volatile("s_waitcnt vmcnt(0)" ::: "memory");
        __builtin_amdgcn_s_barrier();
        if (wr == 0 && wc == 0) {
            unsigned* c = cnt + 64 * u.pm;
            if (fr == 0 && fq == 0) __hip_atomic_fetch_add(c, 1u, __ATOMIC_RELAXED, __HIP_MEMORY_SCOPE_AGENT);
            unsigned sp = 0; while ((unsigned)__builtin_amdgcn_readfirstlane(__hip_atomic_load(c, __ATOMIC_RELAXED, __HIP_MEMORY_SCOPE_AGENT)) < 16u) { __builtin_amdgcn_s_sleep(2); if (++sp > (1u << 24)) break; }
        }
        __builtin_amdgcn_s_barrier();
        asm volatile("" ::: "memory");
        float tot[8];
#pragma unroll
        for (int g = 0; g < 8; ++g) tot[g] = __hip_atomic_load(ssqt + row0 + (g >> 2) * HALF + (g & 3) * 16, __ATOMIC_RELAXED, __HIP_MEMORY_SCOPE_AGENT);
#pragma unroll
        for (int g = 0; g < 8; ++g) { const int ai = g >> 2, m = g & 3; const int row = row0 + ai * HALF + m * 16;
            const float rs = 1.0f / sqrtf(tot[g] * (1.0f / D) + EPS);
            float* orow = out + (size_t)row * D + col0;
#pragma unroll
            for (int bj = 0; bj < 2; ++bj)
#pragma unroll
                for (int n = 0; n < 2; ++n) *(f32x4*)(orow + bj * HALF + 16 * n) = xv[g & 1][bj][n] + acc[ai][bj][m][n] * rs * gg[bj][n];
            if (g + 2 < 8) { const int g2 = g + 2; const float* xr = x + (size_t)(row0 + (g2 >> 2) * HALF + (g2 & 3) * 16) * D + col0;
#pragma unroll
                for (int bj = 0; bj < 2; ++bj)
#pragma unroll
                    for (int n = 0; n < 2; ++n) xv[g & 1][bj][n] = __builtin_nontemporal_load((const f32x4*)(xr + bj * HALF + 16 * n)); } }
    }
};
struct PanelOrder {
    int c;
    __host__ __device__ bool next(int i, Unit& u) const { if (i >= 2) return false; const int xx = c & 7, k = c >> 3; u.pm = 16 * i + 4 * (xx >> 1) + (k & 3); u.pn = 8 * (xx & 1) + (k >> 2); u.ks = 0; return true; }
};

template <class Epi, class Sched, bool ALIGN_EPI = true>
__device__ __forceinline__ void gemm_phase(LAS unsigned char* lds, const Gemm g, const Sched& S, const Epi& E) {
    const int tid = threadIdx.x, wid = __builtin_amdgcn_readfirstlane(tid >> 6), lane = tid & 63, wr = wid >> 2, wc = wid & 3, fr = lane & 15, fq = lane >> 4;
    const int K = g.ld, nt = g.kloop / BK;
    unsigned voffA[2], voffB[2];
#pragma unroll
    for (int i = 0; i < 2; ++i) { int R, C; stage_rc(tid * 16 + i * 8192, R, C); const int Rb = (Epi::PERM == 1) ? ((R & ~31) + perm32(R & 31)) : ((Epi::PERM == 2) ? perm_rope(R) : ((Epi::PERM == 3) ? perm_wide(R, 0) : R));
        voffA[i] = (unsigned)(R * K + C) * 2u; voffB[i] = (unsigned)(Rb * K + C) * 2u; }
    const size_t h1step = (size_t)((Epi::PERM == 3) ? 64 : HALF) * K * 2;
    const size_t kstep = (size_t)(BK * 2);
    const size_t hstep = (size_t)HALF * K * 2;
    const size_t tstep = 2 * hstep;
    const size_t ksplit = (size_t)g.kloop * 2;
    const unsigned ldsw = (unsigned)wid * 1024u;
    const int aoff = lds_byte(wr * 64 + fr, fq * 8), boff = lds_byte(wc * 32 + fr, fq * 8);
#define PG8_SA(b, h) (((b) * 2 + (h)) * HTB)
#define PG8_SB(b, h) ((4 + (b) * 2 + (h)) * HTB)
#define PG8_STAGE(bufoff, gbase, voff) do { _Pragma("unroll") for (int _i = 0; _i < 2; ++_i) \
        __builtin_amdgcn_global_load_lds((const unsigned*)((const char*)(gbase) + (voff)[_i]), (LAS unsigned*)(lds + (bufoff) + ldsw + _i * 8192), 16, 0, 0); } while (0)
#define PG8_LDA(dst, b, h) do { _Pragma("unroll") for (int m = 0; m < 4; ++m) _Pragma("unroll") for (int k = 0; k < 2; ++k) dst[m][k] = *(const LAS bf16x8*)(lds + PG8_SA(b, h) + aoff + m * 2048 + k * 1024); } while (0)
#define PG8_LDB(dst, b, h) do { _Pragma("unroll") for (int n = 0; n < 2; ++n) _Pragma("unroll") for (int k = 0; k < 2; ++k) dst[n][k] = *(const LAS bf16x8*)(lds + PG8_SB(b, h) + boff + n * 2048 + k * 1024); } while (0)
#define PG8_MMA(ai, bj, At, Bt) do { __builtin_amdgcn_s_setprio(1); _Pragma("unroll") for (int m = 0; m < 4; ++m) _Pragma("unroll") for (int n = 0; n < 2; ++n) _Pragma("unroll") for (int k = 0; k < 2; ++k) \
        acc[ai][bj][m][n] = __builtin_amdgcn_mfma_f32_16x16x32_bf16(Bt[n][k], At[m][k], acc[ai][bj][m][n], 0, 0, 0); __builtin_amdgcn_s_setprio(0); } while (0)
#define PG8_WAIT_V(n) asm volatile("s_waitcnt vmcnt(" #n ")" ::: "memory")
#define PG8_WAIT_L(n) asm volatile("s_waitcnt lgkmcnt(" #n ")" ::: "memory")
#define PG8_BAR __builtin_amdgcn_s_barrier()
#define PG8_SCHED __builtin_amdgcn_sched_barrier(0)
    Unit cur, nxt; int ui = 0;
    if (!S.next(0, cur)) return;
    f32x4 acc[2][2][4][2];
#pragma unroll
    for (int a = 0; a < 2; ++a)
#pragma unroll
        for (int b = 0; b < 2; ++b)
#pragma unroll
            for (int m = 0; m < 4; ++m)
#pragma unroll
                for (int n = 0; n < 2; ++n) acc[a][b][m][n] = (f32x4){0.f, 0.f, 0.f, 0.f};
    bf16x8 At[4][2], B0[2][2], B1[2][2];
    const char* cA = (const char*)g.A + (size_t)cur.pm * tstep + (size_t)cur.ks * ksplit; const char* cB = (const char*)g.Bt + (size_t)cur.pn * tstep + (size_t)cur.ks * ksplit;
    PG8_STAGE(PG8_SB(0, 0), cB, voffB); PG8_STAGE(PG8_SB(0, 1), cB + h1step, voffB); PG8_STAGE(PG8_SA(0, 0), cA, voffA); PG8_STAGE(PG8_SA(0, 1), cA + hstep, voffA);
    if (wr == 1) PG8_BAR;
    PG8_WAIT_V(2); PG8_BAR;
    PG8_STAGE(PG8_SB(1, 0), cB + kstep, voffB); PG8_STAGE(PG8_SA(1, 0), cA + kstep, voffA); PG8_STAGE(PG8_SB(1, 1), cB + h1step + kstep, voffB);
    PG8_WAIT_V(6); PG8_BAR;
    for (;;) {
        const bool has_next = S.next(ui + 1, nxt);
        const char* nA = has_next ? (const char*)g.A + (size_t)nxt.pm * tstep + (size_t)nxt.ks * ksplit : cA; const char* nB = has_next ? (const char*)g.Bt + (size_t)nxt.pn * tstep + (size_t)nxt.ks * ksplit : cB;
        for (int t = 0; t < nt; t += 2) {
            const bool last = (t == nt - 2);
            const char* a1 = cA + (size_t)(t + 1) * kstep;
            const char* a2 = last ? nA : cA + (size_t)(t + 2) * kstep; const char* b2 = last ? nB : cB + (size_t)(t + 2) * kstep;
            const char* a3 = a2 + kstep; const char* b3 = b2 + kstep;
            PG8_LDB(B0, 0, 0); PG8_LDB(B1, 0, 1); PG8_SCHED; PG8_LDA(At, 0, 0); PG8_STAGE(PG8_SA(1, 1), a1 + hstep, voffA);
            PG8_WAIT_V(8); PG8_WAIT_L(0); PG8_BAR; PG8_MMA(0, 0, At, B0); PG8_MMA(0, 1, At, B1); PG8_BAR; PG8_SCHED;
            PG8_LDA(At, 0, 1); PG8_STAGE(PG8_SB(0, 0), b2, voffB); PG8_STAGE(PG8_SB(0, 1), b2 + h1step, voffB); PG8_STAGE(PG8_SA(0, 0), a2, voffA);
            PG8_WAIT_V(8); PG8_WAIT_L(0); PG8_BAR; PG8_MMA(1, 0, At, B0); PG8_MMA(1, 1, At, B1); PG8_BAR; PG8_SCHED;
            PG8_LDB(B0, 1, 0); PG8_LDB(B1, 1, 1); PG8_SCHED; PG8_LDA(At, 1, 0); PG8_STAGE(PG8_SA(0, 1), a2 + hstep, voffA);
            PG8_WAIT_V(8); PG8_WAIT_L(0); PG8_BAR; PG8_MMA(0, 0, At, B0); PG8_MMA(0, 1, At, B1); PG8_BAR; PG8_SCHED;
            PG8_LDA(At, 1, 1); PG8_STAGE(PG8_SB(1, 0), b3, voffB); PG8_STAGE(PG8_SB(1, 1), b3 + h1step, voffB); PG8_STAGE(PG8_SA(1, 0), a3, voffA);
            PG8_WAIT_V(8); PG8_WAIT_L(0); PG8_BAR; PG8_MMA(1, 0, At, B0); PG8_MMA(1, 1, At, B1); PG8_BAR; PG8_SCHED;
        }
        if constexpr (ALIGN_EPI) { if (wr == 0) PG8_BAR; }
        E(acc, cur, wr, wc, fr, fq);
        if (!has_next) break;
#pragma unroll
        for (int a = 0; a < 2; ++a)
#pragma unroll
            for (int b = 0; b < 2; ++b)
#pragma unroll
                for (int m = 0; m < 4; ++m)
#pragma unroll
                    for (int n = 0; n < 2; ++n) acc[a][b][m][n] = (f32x4){0.f, 0.f, 0.f, 0.f};
        cur = nxt; cA = nA; cB = nB; ++ui;
        if constexpr (ALIGN_EPI) { if (wr == 1) PG8_BAR; }
    }
    PG8_WAIT_V(0);
    if constexpr (!ALIGN_EPI) { if (wr == 0) PG8_BAR; }
    PG8_BAR;
#undef PG8_SA
#undef PG8_SB
#undef PG8_STAGE
#undef PG8_LDA
#undef PG8_LDB
#undef PG8_MMA
#undef PG8_WAIT_V
#undef PG8_WAIT_L
#undef PG8_BAR
#undef PG8_SCHED
}
}

__host__ __device__ __forceinline__ int win_row_of_col64(int c) {
    if (c < UC || c >= QX) return c;
    const int sec = (c - UC) / 1536, ch = (c - UC) - sec * 1536;
    const int grp = (sec == 0) ? 0 : ((sec == 2) ? 1 : ((sec == 1) ? 2 : 3));
    return UC + (ch >> 6) * 256 + grp * 64 + (ch & 63);
}
__device__ __forceinline__ void transpose_item(const float* __restrict__ W, int K, int N, bf16_t* __restrict__ WT, LAS float* scr, int item, int lane, bool regroup = false) {
    const int nblk = N >> 6, kb = item / nblk, nb = item - kb * nblk, k0 = kb << 6, n0 = nb << 6;
    const int l16 = lane & 15, l4 = lane >> 4;
    f32x4 v[16];
#pragma unroll
    for (int i = 0; i < 16; ++i) v[i] = __builtin_nontemporal_load((const f32x4*)(W + (size_t)(k0 + 4 * i + l4) * N + n0 + 4 * l16));
#pragma unroll
    for (int i = 0; i < 16; ++i) { LAS float* d = scr + (4 * i + l4) * 65 + 4 * l16; d[0] = v[i][0]; d[1] = v[i][1]; d[2] = v[i][2]; d[3] = v[i][3]; }
    asm volatile("s_waitcnt lgkmcnt(0)" ::: "memory");
    const int c = lane & 7, nr = lane >> 3;
#pragma unroll
    for (int j = 0; j < 8; ++j) { const int n = nr + 8 * j; const LAS float* s = scr + (8 * c) * 65 + n;
        u32x4 o; o.x = cvt_pk(s[0], s[65]); o.y = cvt_pk(s[2 * 65], s[3 * 65]); o.z = cvt_pk(s[4 * 65], s[5 * 65]); o.w = cvt_pk(s[6 * 65], s[7 * 65]);
        *(u32x4*)(WT + (size_t)((regroup ? win_row_of_col64(n0) : n0) + n) * K + k0 + 8 * c) = o; }
    asm volatile("s_waitcnt lgkmcnt(0)" ::: "memory");
}
__device__ __forceinline__ void rms_row_to_bf16(const float* __restrict__ xrow, const float* __restrict__ gain, bf16_t* __restrict__ orow, int lane) {
    const f32x4* xr = (const f32x4*)xrow + lane; const f32x4* gr = (const f32x4*)gain + lane;
    f32x4 v[16]; float s = 0.f;
#pragma unroll
    for (int j = 0; j < 16; ++j) { v[j] = __builtin_nontemporal_load(xr + 64 * j); s += (v[j][0] * v[j][0] + v[j][1] * v[j][1]) + (v[j][2] * v[j][2] + v[j][3] * v[j][3]); }
    const float rs = 1.0f / sqrtf(wave_sum(s) * (1.0f / D) + EPS);
    u32x2* o8 = (u32x2*)orow + lane;
#pragma unroll
    for (int j = 0; j < 16; ++j) { const f32x4 gg = gr[64 * j]; u32x2 w; w.x = cvt_pk(v[j][0] * rs * gg[0], v[j][1] * rs * gg[1]); w.y = cvt_pk(v[j][2] * rs * gg[2], v[j][3] * rs * gg[3]); o8[64 * j] = w; }
}

typedef short v4i16_t __attribute__((ext_vector_type(4)));
__device__ __forceinline__ s16x4 vtr(const LAS unsigned char* p) { return __builtin_bit_cast(s16x4, __builtin_amdgcn_ds_read_tr16_b64_v4i16((LAS v4i16_t*)p)); }
__device__ __forceinline__ bf16x8 cat8(s16x4 lo, s16x4 hi) { return (bf16x8){lo[0], lo[1], lo[2], lo[3], hi[0], hi[1], hi[2], hi[3]}; }
__device__ __forceinline__ bf16x8 pk8(u32x2 a, u32x2 b) { u32x4 t; t.x = a.x; t.y = a.y; t.z = b.x; t.w = b.y; return __builtin_bit_cast(bf16x8, t); }

constexpr int AK_STRIDE = 272, AV_STRIDE = 288, AV_OFF = 256 * AK_STRIDE;
__device__ __forceinline__ void attnA_unit(LAS unsigned char* lds, const bf16_t* __restrict__ PROJ, bf16_t* __restrict__ OA, float* __restrict__ LSE, int uidx) {
    const int tid = threadIdx.x, lane = tid & 63, wid = __builtin_amdgcn_readfirstlane(tid >> 6), fr = lane & 15, fq = lane >> 4;
    const int b = uidx / 192, rem = uidx - b * 192, h = rem >> 4, k16 = rem & 15, g = h >> 2, sh = 2 * g, d = 1 << sh, nbk = 16 >> sh;
    const int r = k16 >> (4 - sh), n = k16 & (nbk - 1);
    const size_t rowbase = (size_t)b * SEQ + r;
    LAS unsigned char* Ks = lds; LAS unsigned char* Vs = lds + AV_OFF;
    {
        u32x4 kv[8], vv[8];
#pragma unroll
        for (int it = 0; it < 8; ++it) { const int id = tid + 512 * it, kk = id >> 4, c = id & 15; int i = 128 * (n - 1) + kk; i = i < 0 ? 0 : i;
            const bf16_t* src = PROJ + (rowbase + (size_t)i * d) * NIN + h * 128 + c * 8; kv[it] = *(const u32x4*)(src + KA); vv[it] = *(const u32x4*)(src + VA); }
#pragma unroll
        for (int it = 0; it < 8; ++it) { const int id = tid + 512 * it, kk = id >> 4, c = id & 15; *(LAS u32x4*)(Ks + kk * AK_STRIDE + c * 16) = kv[it]; *(LAS u32x4*)(Vs + kk * AV_STRIDE + c * 16) = vv[it]; }
    }
    const size_t qrow = rowbase + (size_t)(128 * n + 16 * wid + fr) * d;
    bf16x8 qf[4];
#pragma unroll
    for (int kk = 0; kk < 4; ++kk) qf[kk] = *(const bf16x8*)(PROJ + qrow * NIN + QA + h * 128 + 32 * kk + 8 * fq);
    __syncthreads();
    const bool firstblk = (n == 0);
    f32x4 st[9];
#pragma unroll
    for (int j = 0; j < 9; ++j) { st[j] = (f32x4){0.f, 0.f, 0.f, 0.f}; const int kt = wid + j;
        if (!(firstblk && kt < 8)) {
#pragma unroll
            for (int kk = 0; kk < 4; ++kk) { const bf16x8 a = *(const LAS bf16x8*)(Ks + (16 * kt + fr) * AK_STRIDE + (32 * kk + 8 * fq) * 2); st[j] = __builtin_amdgcn_mfma_f32_16x16x32_bf16(a, qf[kk], st[j], 0, 0, 0); }
        } }
    const float sc = 0.08838834764831845f * LOG2E; float mx = -INFINITY;
#pragma unroll
    for (int j = 0; j < 9; ++j)
#pragma unroll
        for (int jj = 0; jj < 4; ++jj) { const int kl = 4 * fq + jj; bool valid = !(firstblk && (wid + j) < 8); if (j == 0) valid = valid && (kl >= fr); if (j == 8) valid = valid && (kl <= fr);
            const float s = valid ? st[j][jj] * sc : -INFINITY; st[j][jj] = s; mx = fmaxf(mx, s); }
    mx = fmaxf(mx, __shfl_xor(mx, 16)); mx = fmaxf(mx, __shfl_xor(mx, 32));
    float l = 0.f; u32x2 pk[9];
#pragma unroll
    for (int j = 0; j < 9; ++j) { float p[4];
#pragma unroll
        for (int jj = 0; jj < 4; ++jj) { p[jj] = __builtin_amdgcn_exp2f(st[j][jj] - mx); l += p[jj]; }
        pk[j].x = cvt_pk(p[0], p[1]); pk[j].y = cvt_pk(p[2], p[3]); }
    l += __shfl_xor(l, 16); l += __shfl_xor(l, 32);
    f32x4 o[8];
    const LAS unsigned char* vbase = Vs + (16 * wid + 4 * fq + ((lane >> 2) & 3)) * AV_STRIDE + (lane & 3) * 8;
    const u32x2 zz = (u32x2){0u, 0u};
#pragma unroll
    for (int dt = 0; dt < 8; ++dt) { o[dt] = (f32x4){0.f, 0.f, 0.f, 0.f};
#pragma unroll
        for (int p = 0; p < 5; ++p) { const int jA = 2 * p, jB = (p < 4) ? 2 * p + 1 : 8;
            const s16x4 lo = vtr(vbase + 16 * jA * AV_STRIDE + dt * 32), hi = vtr(vbase + 16 * jB * AV_STRIDE + dt * 32);
            o[dt] = __builtin_amdgcn_mfma_f32_16x16x32_bf16(cat8(lo, hi), pk8(pk[jA], (p < 4) ? pk[jB] : zz), o[dt], 0, 0, 0); } }
    const float rl = 1.0f / l;
    bf16_t* op = OA + qrow * 1536 + h * 128 + 4 * fq;
#pragma unroll
    for (int dt = 0; dt < 8; ++dt) { u32x2 w; w.x = cvt_pk(o[dt][0] * rl, o[dt][1] * rl); w.y = cvt_pk(o[dt][2] * rl, o[dt][3] * rl); *(u32x2*)(op + 16 * dt) = w; }
    if (fq == 0) LSE[qrow * 12 + h] = (mx + __builtin_amdgcn_logf(l)) * LN2;
    __syncthreads();
}

constexpr int XK_STRIDE = 528, XV_STRIDE = 544;
__device__ __forceinline__ void attnX_unit(LAS unsigned char* lds, const bf16_t* __restrict__ PROJ, const bf16_t* __restrict__ MK, const bf16_t* __restrict__ MV, bf16_t* __restrict__ Y, const float* __restrict__ C256, const float* __restrict__ S256, int uidx) {
    const int tid = threadIdx.x, lane = tid & 63, wid = __builtin_amdgcn_readfirstlane(tid >> 6), fr = lane & 15, fq = lane >> 4;
    const int b = uidx >> 6, hx = (uidx >> 4) & 3, qb = uidx & 15;
    const size_t qrow = (size_t)b * SEQ + qb * 128 + 16 * wid + fr;
    const bf16_t* kbase = MK + (size_t)b * MEML * 1024 + hx * 256; const bf16_t* vbase_g = MV + (size_t)b * MEML * 1024 + hx * 256;
    bf16x8 qf[8];
#pragma unroll
    for (int kk = 0; kk < 8; ++kk) qf[kk] = *(const bf16x8*)(PROJ + qrow * NIN + QX + hx * 256 + 32 * kk + 8 * fq);
    {
        const int pos = ((int)qrow & (SEQ - 1)) + MEML;
#pragma unroll
        for (int kk = 0; kk < 4; ++kk) { const float* cp = C256 + pos * 128 + 32 * kk + 8 * fq; const float* sp = S256 + pos * 128 + 32 * kk + 8 * fq;
            const f32x4 c0 = *(const f32x4*)cp, c1 = *(const f32x4*)(cp + 4), s0 = *(const f32x4*)sp, s1 = *(const f32x4*)(sp + 4);
            const u32x4 xa = __builtin_bit_cast(u32x4, qf[kk]), xb = __builtin_bit_cast(u32x4, qf[kk + 4]); u32x4 ya, yb;
#pragma unroll
            for (int q = 0; q < 4; ++q) { const float cl = (q < 2) ? c0[2 * q] : c1[2 * q - 4], ch = (q < 2) ? c0[2 * q + 1] : c1[2 * q - 3], sl = (q < 2) ? s0[2 * q] : s1[2 * q - 4], sh = (q < 2) ? s0[2 * q + 1] : s1[2 * q - 3];
                const float a_l = bf_lo(xa[q]), a_h = bf_hi(xa[q]), b_l = bf_lo(xb[q]), b_h = bf_hi(xb[q]);
                ya[q] = cvt_pk(a_l * cl - b_l * sl, a_h * ch - b_h * sh); yb[q] = cvt_pk(b_l * cl + a_l * sl, b_h * ch + a_h * sh); }
            qf[kk] = __builtin_bit_cast(bf16x8, ya); qf[kk + 4] = __builtin_bit_cast(bf16x8, yb); }
    }
    __builtin_amdgcn_sched_barrier(0);
    {
#pragma unroll 2
        for (int it = 0; it < 8; ++it) { const int id = tid + 512 * it, kk = id >> 4, c = id & 15;
            const u32x4 xa = *(const u32x4*)(kbase + (size_t)kk * 1024 + c * 8), xb = *(const u32x4*)(kbase + (size_t)kk * 1024 + 128 + c * 8);
            const float* cp = C256 + kk * 128 + c * 8; const float* sp = S256 + kk * 128 + c * 8;
            const f32x4 c0 = *(const f32x4*)cp, c1 = *(const f32x4*)(cp + 4), s0 = *(const f32x4*)sp, s1 = *(const f32x4*)(sp + 4);
            u32x4 ya, yb;
#pragma unroll
            for (int q = 0; q < 4; ++q) { const float cl = (q < 2) ? c0[2 * q] : c1[2 * q - 4], ch = (q < 2) ? c0[2 * q + 1] : c1[2 * q - 3], sl = (q < 2) ? s0[2 * q] : s1[2 * q - 4], sh = (q < 2) ? s0[2 * q + 1] : s1[2 * q - 3];
                const float a_l = bf_lo(xa[q]), a_h = bf_hi(xa[q]), b_l = bf_lo(xb[q]), b_h = bf_hi(xb[q]);
                ya[q] = cvt_pk(a_l * cl - b_l * sl, a_h * ch - b_h * sh); yb[q] = cvt_pk(b_l * cl + a_l * sl, b_h * ch + a_h * sh); }
            *(LAS u32x4*)(lds + kk * XK_STRIDE + c * 16) = ya; *(LAS u32x4*)(lds + kk * XK_STRIDE + 256 + c * 16) = yb; }
    }
    __syncthreads();
    f32x4 st[16];
#pragma unroll
    for (int j = 0; j < 16; ++j) { st[j] = (f32x4){0.f, 0.f, 0.f, 0.f};
#pragma unroll
        for (int kk = 0; kk < 8; ++kk) { const bf16x8 a = *(const LAS bf16x8*)(lds + (16 * j + fr) * XK_STRIDE + (32 * kk + 8 * fq) * 2); st[j] = __builtin_amdgcn_mfma_f32_16x16x32_bf16(a, qf[kk], st[j], 0, 0, 0); } }
    const float sc = 0.0625f * LOG2E; float mx = -INFINITY;
#pragma unroll
    for (int j = 0; j < 16; ++j)
#pragma unroll
        for (int jj = 0; jj < 4; ++jj) { const float s = st[j][jj] * sc; st[j][jj] = s; mx = fmaxf(mx, s); }
    mx = fmaxf(mx, __shfl_xor(mx, 16)); mx = fmaxf(mx, __shfl_xor(mx, 32));
    float l = 0.f; u32x2 pk[16];
#pragma unroll
    for (int j = 0; j < 16; ++j) { float p[4];
#pragma unroll
        for (int jj = 0; jj < 4; ++jj) { p[jj] = __builtin_amdgcn_exp2f(st[j][jj] - mx); l += p[jj]; }
        pk[j].x = cvt_pk(p[0], p[1]); pk[j].y = cvt_pk(p[2], p[3]); }
    l += __shfl_xor(l, 16); l += __shfl_xor(l, 32);
    __syncthreads();
    {
#pragma unroll
        for (int hf = 0; hf < 2; ++hf) { u32x4 vv[8];
#pragma unroll
            for (int it = 0; it < 8; ++it) { const int id = tid + 512 * (it + 8 * hf), kk = id >> 5, c = id & 31; vv[it] = *(const u32x4*)(vbase_g + (size_t)kk * 1024 + c * 8); }
#pragma unroll
            for (int it = 0; it < 8; ++it) { const int id = tid + 512 * (it + 8 * hf), kk = id >> 5, c = id & 31; *(LAS u32x4*)(lds + kk * XV_STRIDE + c * 16) = vv[it]; } }
    }
    __syncthreads();
    const LAS unsigned char* vb = lds + (4 * fq + ((lane >> 2) & 3)) * XV_STRIDE + (lane & 3) * 8;
    const float rl = 1.0f / l;
    const bf16_t* zp = PROJ + qrow * NIN + ZX + hx * 256 + 4 * fq;
    bf16_t* yp = Y + qrow * D + 3072 + hx * 256 + 4 * fq;
#pragma unroll
    for (int dt = 0; dt < 16; ++dt) { f32x4 o = (f32x4){0.f, 0.f, 0.f, 0.f};
#pragma unroll
        for (int p = 0; p < 8; ++p) { const s16x4 lo = vtr(vb + 16 * (2 * p) * XV_STRIDE + dt * 32), hi = vtr(vb + 16 * (2 * p + 1) * XV_STRIDE + dt * 32);
            o = __builtin_amdgcn_mfma_f32_16x16x32_bf16(cat8(lo, hi), pk8(pk[2 * p], pk[2 * p + 1]), o, 0, 0, 0); }
        const u32x2 zw = *(const u32x2*)(zp + 16 * dt);
        u32x2 w; w.x = cvt_pk(o[0] * rl * silu_f(bf_lo(zw.x)), o[1] * rl * silu_f(bf_hi(zw.x))); w.y = cvt_pk(o[2] * rl * silu_f(bf_lo(zw.y)), o[3] * rl * silu_f(bf_hi(zw.y)));
        *(u32x2*)(yp + 16 * dt) = w; }
    __syncthreads();
}


#define XB_TMO      128
#define XB_XCNT(j)  (256  + 64 * (j))
#define XB_XSUB(j)  (1280 + 64 * (j))
#define XB_XGEN(j)  (2304 + 64 * (j))
#define XB_TOP      3328
#define XB_TOPGEN   3392
#define XCD_BAR_WORDS 3456
#define XB_SPIN_CAP (1u << 22)
__device__ __forceinline__ unsigned xb_ld(unsigned* p)              { return __hip_atomic_load(p, __ATOMIC_RELAXED, __HIP_MEMORY_SCOPE_AGENT); }
__device__ __forceinline__ unsigned xb_add(unsigned* p, unsigned v) { return __hip_atomic_fetch_add(p, v, __ATOMIC_RELAXED, __HIP_MEMORY_SCOPE_AGENT); }
__device__ __forceinline__ unsigned xb_xcc_id() { return (unsigned)__builtin_amdgcn_s_getreg((3 << 11) | 20) & 0xFu; }
#define XB_SPIN(cond, bar) do { unsigned _sp = 0; while (cond) { __builtin_amdgcn_s_sleep(1); \
    if ((++_sp & 255u) == 0u) { if (xb_ld(&(bar)[XB_TMO])) break; if (_sp > XB_SPIN_CAP) { atomicAdd(&(bar)[XB_TMO], 1u); break; } } } } while (0)
struct XcdBarrier { unsigned* bar; unsigned x; volatile LAS unsigned* st; };
__device__ __forceinline__ XcdBarrier xcd_barrier_post(unsigned* bar, volatile LAS unsigned* st) {
    XcdBarrier b; b.bar = bar; b.x = xb_xcc_id(); b.st = st;
    if (threadIdx.x == 0) (void)xb_add(&bar[XB_XCNT(b.x)], 1u);
    return b;
}
__device__ __forceinline__ void xcd_barrier_complete(unsigned* bar, unsigned x, unsigned& nloc, unsigned& nx) {
    const unsigned G = gridDim.x * gridDim.y * gridDim.z;
    unsigned sum, cnt, mine, sp = 0u;
    for (;;) {
        sum = 0u; cnt = 0u; mine = 0u;
#pragma unroll
        for (unsigned j = 0; j < 16; ++j) { const unsigned c = xb_ld(&bar[XB_XCNT(j)]); sum += c; cnt += (c > 0u) ? 1u : 0u; mine = (j == x) ? c : mine; }
        if (sum == G) break;
        __builtin_amdgcn_s_sleep(1);
        if ((++sp & 255u) == 0u) { if (xb_ld(&bar[XB_TMO])) break; if (sp > XB_SPIN_CAP) { atomicAdd(&bar[XB_TMO], 1u); break; } }
    }
    nloc = mine > 0u ? mine : 1u; nx = cnt > 0u ? cnt : 1u;
}
__device__ __forceinline__ void xcd_barrier(const XcdBarrier& b) {
    asm volatile("s_waitcnt vmcnt(0)" ::: "memory");
    __syncthreads();
    if (threadIdx.x == 0) {
        unsigned* bar = b.bar;
        __builtin_amdgcn_s_waitcnt(0);
        unsigned nloc = b.st[0], nx = b.st[1];
        if (nloc == 0u) { xcd_barrier_complete(bar, b.x, nloc, nx); b.st[0] = nloc; b.st[1] = nx; }
        const unsigned old = xb_add(&bar[XB_XSUB(b.x)], 1u);
        const unsigned gen = old / nloc;
        if (old + 1u == (gen + 1u) * nloc) {
            __builtin_amdgcn_fence(__ATOMIC_RELEASE, "agent");
            asm volatile("s_waitcnt vmcnt(0)" ::: "memory");
            const unsigned og = xb_add(&bar[XB_TOP], 1u);
            const unsigned tg = og / nx;
            if (og + 1u == (tg + 1u) * nx) xb_add(&bar[XB_TOPGEN], 1u);
            else XB_SPIN(xb_ld(&bar[XB_TOPGEN]) == tg, bar);
            __builtin_amdgcn_fence(__ATOMIC_ACQUIRE, "agent");
            xb_add(&bar[XB_XGEN(b.x)], 1u);
            asm volatile("s_waitcnt vmcnt(0)" ::: "memory");
        } else {
            XB_SPIN(xb_ld(&bar[XB_XGEN(b.x)]) == gen, bar);
            __builtin_amdgcn_fence(__ATOMIC_ACQUIRE, "agent");
            asm volatile("s_waitcnt vmcnt(0)" ::: "memory");
        }
    }
    __syncthreads();
}

struct Args { const float* in[9]; float* out; unsigned char* ws; int ph_lo, ph_hi; };

__global__ void __launch_bounds__(512, 2) fwd(Args args) {
    extern __shared__ __attribute__((aligned(16))) unsigned char lds_raw[];
    LAS unsigned char* lds = (LAS unsigned char*)lds_raw;
    cg::grid_group grid = cg::this_grid();
    const int tid = threadIdx.x;
    const int G = gridDim.x, bx = blockIdx.x;
    const float* x = args.in[0]; const float* mem = args.in[1]; const float* pre_norm = args.in[2]; const float* w_in = args.in[3]; const float* conv_w = args.in[4];
    const float* mem_norm = args.in[5]; const float* w_mem_kv = args.in[6]; const float* w_out = args.in[7]; const float* post_norm = args.in[8];
    unsigned char* ws = args.ws;
    bf16_t* WIN = (bf16_t*)(ws + WS_WIN); bf16_t* WOUT = (bf16_t*)(ws + WS_WOUT); bf16_t* WMEM = (bf16_t*)(ws + WS_WMEM);
    bf16_t* H = (bf16_t*)(ws + WS_H); bf16_t* MEMN = (bf16_t*)(ws + WS_MEMN); bf16_t* PROJ = (bf16_t*)(ws + WS_PROJ);
    bf16_t* MK = (bf16_t*)(ws + WS_MK); bf16_t* MV = (bf16_t*)(ws + WS_MV);
    bf16_t* OA = (bf16_t*)(ws + WS_OA); float* LSE = (float*)(ws + WS_LSE); bf16_t* Y = (bf16_t*)(ws + WS_Y);
    float* Y2 = (float*)(ws + WS_Y2); float* SSQ = (float*)(ws + WS_SSQ);
    float* C128 = (float*)(ws + WS_C128); float* S128 = (float*)(ws + WS_S128); float* C256 = (float*)(ws + WS_C256); float* S256 = (float*)(ws + WS_S256);
    const int lo = args.ph_lo, hi = args.ph_hi;
#define IN(k) (lo <= (k) && (k) < hi)
#define GBAR() xcd_barrier(bar)
#define SEAM(k) do { if (IN(k) && IN((k) + 1)) GBAR(); } while (0)
    volatile LAS unsigned* misc = (volatile LAS unsigned*)(lds + MISC_OFF);
    if (tid < 16) misc[tid] = 0u;
    __syncthreads();
    XcdBarrier bar = xcd_barrier_post((unsigned*)(ws + WS_BAR), misc);
    if (args.ph_hi > 1000) grid.sync();
    const int NGW = G * 8, NGT = G * 512;
#define PHASE_IDS() int tid_ = threadIdx.x; asm volatile("" : "+v"(tid_)); const int lane = tid_ & 63, wave = __builtin_amdgcn_readfirstlane(tid_ >> 6), gw = bx * 8 + wave, gt = bx * 512 + tid_; (void)lane; (void)wave; (void)gw; (void)gt
    constexpr int I_IN = (D / 64) * (NIN / 64), I_MEM = (D / 64) * (NKV / 64), I_OUT = (D / 64) * (D / 64);

    if (IN(0)) {
        PHASE_IDS();
        LAS float* scr = (LAS float*)(lds + wave * 16640);
        for (int it = gw; it < I_MEM; it += NGW) transpose_item(w_mem_kv, D, NKV, WMEM, scr, it, lane);
        for (int m = gw; m < MM; m += NGW) rms_row_to_bf16(mem + (size_t)m * D, mem_norm, MEMN + (size_t)m * D, lane);
        for (int e = gt; e < 2048 * 64 + 2304 * 128; e += NGT) {
            const bool a = e < 2048 * 64; const int e2 = a ? e : e - 2048 * 64; const int pos = a ? (e2 >> 6) : (e2 >> 7), i = a ? (e2 & 63) : (e2 & 127);
            const float inv = __builtin_amdgcn_exp2f(-13.287712379549449f * (float)i * (a ? (1.0f / 64.0f) : (1.0f / 128.0f)));
            const float rev = __builtin_amdgcn_fractf((float)pos * inv * 0.15915494309189535f);
            const float c = __builtin_amdgcn_cosf(rev), sn = __builtin_amdgcn_sinf(rev);
            if (a) { C128[e2] = c; S128[e2] = sn; } else { C256[e2] = c; S256[e2] = sn; }
        }
    }
    SEAM(0);

    if (IN(1)) {
        const bool desig = ((bx >> 3) & 7) == 0;
        const int nd = ((G >> 6) << 3) + (((G & 63) < 8) ? (G & 63) : 8);
        if (desig) { pg8::Gemm g{MEMN, WMEM, D, D}; pg8::MemOrder S{nd, ((bx >> 6) << 3) + (bx & 7)}; pg8::EpiMem E{MK, MV};
            pg8::gemm_phase<pg8::EpiMem, pg8::MemOrder>(lds, g, S, E); }
        else {
            PHASE_IDS();
            LAS float* scr = (LAS float*)(lds + wave * 16640);
            const int gwb = ((bx >> 6) * 56 + (bx & 63) - 8) * 8 + wave, NGWB = (G - nd) * 8;
            for (int it = gwb; it < I_IN + I_OUT; it += NGWB) { if (it < I_IN) transpose_item(w_in, D, NIN, WIN, scr, it, lane, true); else transpose_item(w_out, D, D, WOUT, scr, it - I_IN, lane); }
            for (int m = NGWB - 1 - gwb; m < M; m += NGWB) rms_row_to_bf16(x + (size_t)m * D, pre_norm, H + (size_t)m * D, lane);
        }
    }
    SEAM(1);

    if (IN(2)) { pg8::Gemm g{H, WIN, D, D}; pg8::StaticOrder S; S.init(M, NIN, G, bx); pg8::EpiProj E{PROJ, C128, S128};
        pg8::gemm_phase<pg8::EpiProj, pg8::StaticOrder>(lds, g, S, E); }
    SEAM(2);

    if (IN(3)) {
        const bool attn_first = ((bx >> 3) & 1) == 0;
        if (!attn_first) {
        PHASE_IDS();
        for (int id = gt; id < M * 192; id += NGT) {
            const int row = id / 192, c8 = (id - row * 192) * 8, t = row & (SEQ - 1);
            const bf16_t* pr = PROJ + (size_t)row * NIN + c8;
            const u32x4 p0 = *(const u32x4*)(pr + UC), gg = *(const u32x4*)(pr + BC);
            u32x4 p1 = (u32x4){0u, 0u, 0u, 0u}, p2 = p1;
            if (t >= 1) p1 = *(const u32x4*)(pr - NIN + UC);
            if (t >= 2) p2 = *(const u32x4*)(pr - 2 * NIN + UC);
            float w0[8], w1[8], w2[8];
#pragma unroll
            for (int e = 0; e < 8; ++e) { w0[e] = conv_w[c8 + e]; w1[e] = conv_w[1536 + c8 + e]; w2[e] = conv_w[3072 + c8 + e]; }
            float y[8];
#pragma unroll
            for (int q = 0; q < 4; ++q) {
                y[2 * q] = bf_lo(gg[q]) * (bf_lo(p2[q]) * w0[2 * q] + bf_lo(p1[q]) * w1[2 * q] + bf_lo(p0[q]) * w2[2 * q]);
                y[2 * q + 1] = bf_hi(gg[q]) * (bf_hi(p2[q]) * w0[2 * q + 1] + bf_hi(p1[q]) * w1[2 * q + 1] + bf_hi(p0[q]) * w2[2 * q + 1]);
            }
            u32x4 w; w.x = cvt_pk(y[0], y[1]); w.y = cvt_pk(y[2], y[3]); w.z = cvt_pk(y[4], y[5]); w.w = cvt_pk(y[6], y[7]);
            *(u32x4*)(Y + (size_t)row * D + 1536 + c8) = w;
        }
        }
        for (int u = bx; u < 768; u += G) attnA_unit(lds, PROJ, OA, LSE, u);
        for (int u = bx; u < 256; u += G) attnX_unit(lds, PROJ, MK, MV, Y, C256, S256, u);
        if (attn_first) {
        PHASE_IDS();
        for (int id = gt; id < M * 192; id += NGT) {
            const int row = id / 192, c8 = (id - row * 192) * 8, t = row & (SEQ - 1);
            const bf16_t* pr = PROJ + (size_t)row * NIN + c8;
            const u32x4 p0 = *(const u32x4*)(pr + UC), gg = *(const u32x4*)(pr + BC);
            u32x4 p1 = (u32x4){0u, 0u, 0u, 0u}, p2 = p1;
            if (t >= 1) p1 = *(const u32x4*)(pr - NIN + UC);
            if (t >= 2) p2 = *(const u32x4*)(pr - 2 * NIN + UC);
            float w0[8], w1[8], w2[8];
#pragma unroll
            for (int e = 0; e < 8; ++e) { w0[e] = conv_w[c8 + e]; w1[e] = conv_w[1536 + c8 + e]; w2[e] = conv_w[3072 + c8 + e]; }
            float y[8];
#pragma unroll
            for (int q = 0; q < 4; ++q) {
                y[2 * q] = bf_lo(gg[q]) * (bf_lo(p2[q]) * w0[2 * q] + bf_lo(p1[q]) * w1[2 * q] + bf_lo(p0[q]) * w2[2 * q]);
                y[2 * q + 1] = bf_hi(gg[q]) * (bf_hi(p2[q]) * w0[2 * q + 1] + bf_hi(p1[q]) * w1[2 * q + 1] + bf_hi(p0[q]) * w2[2 * q + 1]);
            }
            u32x4 w; w.x = cvt_pk(y[0], y[1]); w.y = cvt_pk(y[2], y[3]); w.z = cvt_pk(y[4], y[5]); w.w = cvt_pk(y[6], y[7]);
            *(u32x4*)(Y + (size_t)row * D + 1536 + c8) = w;
        }
        }
    }
    SEAM(3);

    if (IN(4)) {
        PHASE_IDS();
        if (G == 256) {
            const char* src = (const char*)WOUT + ((size_t)bx * 8 + wave) * 16384 + lane * 16;
#pragma unroll
            for (int i = 0; i < 16; ++i) __builtin_amdgcn_global_load_lds((const unsigned*)(src + i * 1024), (LAS unsigned*)(lds + wave * 1024), 16, 0, 0);
        }
        for (int id = gt; id < M * 192; id += NGT) {
            const int row = id / 192, c = id - row * 192, h = c >> 4, j = h & 3;
            const float l0 = LSE[row * 12 + j], l1 = LSE[row * 12 + 4 + j], l2 = LSE[row * 12 + 8 + j];
            const float mxl = fmaxf(l0, fmaxf(l1, l2)); const float e0 = __expf(l0 - mxl), e1 = __expf(l1 - mxl), e2 = __expf(l2 - mxl);
            const float lh = (h < 4) ? e0 : ((h < 8) ? e1 : e2); const float alpha = lh / (e0 + e1 + e2);
            const u32x4 ov = *(const u32x4*)(OA + (size_t)row * 1536 + c * 8), zv = *(const u32x4*)(PROJ + (size_t)row * NIN + ZA + c * 8);
            u32x4 w;
#pragma unroll
            for (int q = 0; q < 4; ++q) w[q] = cvt_pk(bf_lo(ov[q]) * alpha * silu_f(bf_lo(zv[q])), bf_hi(ov[q]) * alpha * silu_f(bf_hi(zv[q])));
            *(u32x4*)(Y + (size_t)row * D + c * 8) = w;
        }
    }
    SEAM(4);

    const bool fused_out = FUSED_OUT && (G == 256);
    if (IN(5)) {
        if (fused_out) { pg8::Gemm g{Y, WOUT, D, D}; pg8::PanelOrder S{bx}; pg8::EpiOut E{x, post_norm, args.out, (float*)(ws + WS_BAR) + 8192, (unsigned*)(ws + WS_BAR) + 4096};
            pg8::gemm_phase<pg8::EpiOut, pg8::PanelOrder>(lds, g, S, E); }
        else { pg8::Gemm g{Y, WOUT, D, D}; pg8::StaticOrder S; S.init(M, D, G, bx); pg8::EpiY2 E{Y2, SSQ};
            pg8::gemm_phase<pg8::EpiY2, pg8::StaticOrder>(lds, g, S, E);
            }
    }
    if (!fused_out) SEAM(5);

    if (IN(6) && !fused_out) {
        PHASE_IDS();
        float* out = args.out;
        for (int m = gw; m < M; m += NGW) {
            const float ss = wave_sum(SSQ[(size_t)m * 64 + lane]);
            const float rs = 1.0f / sqrtf(ss * (1.0f / D) + EPS);
            const f32x4* yr = (const f32x4*)(Y2 + (size_t)m * D) + lane; const f32x4* xr = (const f32x4*)(x + (size_t)m * D) + lane; const f32x4* gr = (const f32x4*)post_norm + lane;
            f32x4* orow = (f32x4*)(out + (size_t)m * D) + lane;
#pragma unroll 4
            for (int j = 0; j < 16; ++j) { const f32x4 yv = yr[64 * j], xv = xr[64 * j], gg = gr[64 * j]; orow[64 * j] = xv + yv * rs * gg; }
        }
    }
#undef PHASE_IDS
#undef IN
#undef SEAM
}

extern "C" void kernel_launch(void* const* d_in, const int* in_sizes, int n_in, void* d_out, int out_size, void* d_ws, size_t ws_size, hipStream_t stream) {
    static int grid = 0;
    if (grid == 0) {
        if (n_in != 9 || out_size != M * D || ws_size < WS_END) { fprintf(stderr, "kernel_launch: unexpected shapes (n_in %d out %d ws %zu)\n", n_in, out_size, ws_size); grid = -1; return; }
        int dev = 0, cus = 0, per_cu = 0;
        if (hipGetDevice(&dev) != hipSuccess || hipDeviceGetAttribute(&cus, hipDeviceAttributeMultiprocessorCount, dev) != hipSuccess) { grid = -1; return; }
        if (hipFuncSetAttribute((const void*)fwd, hipFuncAttributeMaxDynamicSharedMemorySize, LDS_BYTES) != hipSuccess) { fprintf(stderr, "kernel_launch: hipFuncSetAttribute failed\n"); grid = -1; return; }
        if (hipOccupancyMaxActiveBlocksPerMultiprocessor(&per_cu, (const void*)fwd, 512, LDS_BYTES) != hipSuccess || per_cu < 1) { fprintf(stderr, "kernel_launch: occupancy query says %d blocks/CU\n", per_cu); (void)hipGetLastError(); grid = -1; return; }
        grid = cus * per_cu;
    }
    if (grid < 0) return;
    if (hipMemsetAsync((char*)d_ws + WS_BAR, 0, 65536, stream) != hipSuccess) { fprintf(stderr, "kernel_launch: memset failed\n"); return; }
    Args a{};
    for (int i = 0; i < 9; ++i) a.in[i] = (const float*)d_in[i];
    a.out = (float*)d_out; a.ws = (unsigned char*)d_ws;
#if N_LAUNCH_MODE == 1
    a.ph_lo = 0; a.ph_hi = 7;
    void* kargs[] = {&a};
    hipError_t e = hipLaunchCooperativeKernel((const void*)fwd, dim3(grid), dim3(512), kargs, LDS_BYTES, stream);
    if (e != hipSuccess) fprintf(stderr, "cooperative launch failed: %s (grid %d)\n", hipGetErrorString(e), grid);
#else
    for (int ph = 0; ph < 7; ++ph) { a.ph_lo = ph; a.ph_hi = ph + 1; hipLaunchKernelGGL(fwd, dim3(grid), dim3(512), LDS_BYTES, stream, a); }
#endif
}
```

```cpp
#include <hip/hip_runtime.h>
#include <hip/hip_cooperative_groups.h>
#include <cstdio>
#include <cstdint>
namespace cg = cooperative_groups;

#ifndef N_LAUNCH_MODE
#define N_LAUNCH_MODE 1
#endif

#ifndef FUSED_OUT
#define FUSED_OUT 1
#endif
#define LAS __attribute__((address_space(3)))
typedef unsigned short bf16_t;
typedef short bf16x8 __attribute__((ext_vector_type(8)));
typedef short s16x4 __attribute__((ext_vector_type(4)));
typedef float f32x4 __attribute__((ext_vector_type(4)));
typedef unsigned u32x4 __attribute__((ext_vector_type(4)));
typedef unsigned u32x2 __attribute__((ext_vector_type(2)));

constexpr int SEQ = 2048, BATCH = 4, M = BATCH * SEQ, D = 4096, NIN = 14336, MEML = 256, MM = BATCH * MEML;
constexpr int QA = 0, KA = 1536, VA = 3072, ZA = 4608, UC = 6144, BC = 7680, CC = 9216, ZC = 10752, QX = 12288, ZX = 13312;
constexpr int NKV = 2048, KSPLIT = 8;
constexpr float EPS = 1e-6f;
constexpr float LOG2E = 1.4426950408889634f, LN2 = 0.6931471805599453f;

constexpr size_t MiB = 1u << 20;
constexpr size_t WS_WIN = 0;
constexpr size_t WS_WOUT = 112 * MiB;
constexpr size_t WS_WMEM = 144 * MiB;
constexpr size_t WS_H = 160 * MiB;
constexpr size_t WS_MEMN = 224 * MiB;
constexpr size_t WS_PROJ = 232 * MiB;
constexpr size_t WS_MK = 520 * MiB;
constexpr size_t WS_MV = 522 * MiB;
constexpr size_t WS_OA = 524 * MiB;
constexpr size_t WS_LSE = 548 * MiB;
constexpr size_t WS_Y = 549 * MiB;
constexpr size_t WS_Y2 = 613 * MiB;
constexpr size_t WS_SSQ = 741 * MiB;
constexpr size_t WS_C128 = 743 * MiB;
constexpr size_t WS_S128 = WS_C128 + 2048 * 64 * 4;
constexpr size_t WS_C256 = 744 * MiB;
constexpr size_t WS_S256 = WS_C256 + 2304 * 128 * 4;
constexpr size_t WS_BAR = 747 * MiB;
constexpr size_t WS_END = 748 * MiB;

constexpr int LDS_BYTES = 147456;
constexpr int MISC_OFF = LDS_BYTES - 64;

__device__ __forceinline__ unsigned cvt_pk(float lo, float hi) { unsigned r; asm("v_cvt_pk_bf16_f32 %0, %1, %2" : "=v"(r) : "v"(lo), "v"(hi)); return r; }
__device__ __forceinline__ float bf_lo(unsigned u) { return __uint_as_float(u << 16); }
__device__ __forceinline__ float bf_hi(unsigned u) { return __uint_as_float(u & 0xffff0000u); }
__device__ __forceinline__ float silu_f(float z) { return z / (1.0f + __expf(-z)); }
__device__ __forceinline__ float wave_sum(float v) {
#pragma unroll
    for (int o = 1; o < 64; o <<= 1) v += __shfl_xor(v, o);
    return v;
}

namespace pg8 {
constexpr int BM = 256, BK = 64, HALF = 128, HTB = HALF * BK * 2, STAGE_BYTES = 8 * HTB, NXCD = 8, WGM = 4;
__host__ __device__ __forceinline__ int lds_byte(int r, int c) { const int st = (r >> 4) * 2 + (c >> 5), rr = r & 15, cc = c & 31, ob = rr * 64 + cc * 2; return st * 1024 + (ob ^ (((ob >> 9) & 1) << 5)); }
__host__ __device__ __forceinline__ void stage_rc(int b, int& R, int& C) { const int st = b / 1024, sb = b % 1024, swz = sb ^ (((sb >> 9) & 1) << 5); R = (st >> 1) * 16 + swz / 64; C = (st & 1) * 32 + (swz % 64) / 2; }
__host__ __device__ __forceinline__ int perm32(int rho) { const int n = rho >> 4, i = rho & 15; return 8 * (i >> 2) + 4 * n + (i & 3); }
__host__ __device__ __forceinline__ int perm_rope(int R) { const int wc = R >> 5, n = (R >> 4) & 1, i = R & 15; return 64 * n + 16 * wc + i; }

__host__ __device__ __forceinline__ int perm_wide(int R, int h) { const int wc = R >> 5, n = (R >> 4) & 1, fq = (R >> 2) & 3, j = R & 3; return 128 * (wc >> 1) + 64 * h + 32 * (wc & 1) + 8 * fq + 4 * n + j; }

struct Unit { int pm, pn, ks; };
struct Gemm { const bf16_t* A; const bf16_t* Bt; int ld; int kloop; };

struct StaticOrder {
    int nM, nN, nwg, G, c;
    __host__ __device__ void init(int M_, int N_, int G_, int c_) { nM = M_ / BM; nN = N_ / BM; nwg = nM * nN; G = G_; c = c_; }
    __host__ __device__ bool next(int i, Unit& u) const {
        const long L = (long)i * G + c; if (L >= nwg) return false;
        int wgid = (int)L; { const int q = nwg / NXCD, r = nwg % NXCD, xcd = wgid % NXCD, off = wgid / NXCD; wgid = (xcd < r ? xcd * (q + 1) : r * (q + 1) + (xcd - r) * q) + off; }
        const int nig = WGM * nN, gid = wgid / nig, fm = gid * WGM, gsz = (nM - fm) < WGM ? (nM - fm) : WGM;
        u.pm = fm + ((wgid % nig) % gsz); u.pn = (wgid % nig) / gsz; u.ks = 0; return true;
    }
};
struct MemOrder {
    int nd, di;
    __host__ __device__ bool next(int i, Unit& u) const { const int L = i * nd + di; if (di < 0 || L >= 32) return false; u.pm = L & 3; u.pn = L >> 2; u.ks = 0; return true; }
};

struct EpiProj {
    static constexpr int PERM = 3;
    bf16_t* O; const float *c128, *s128;
    static __device__ __forceinline__ void st16(bf16_t* p, const f32x4 a, const f32x4 b) { u32x4 w; w.x = cvt_pk(a[0], a[1]); w.y = cvt_pk(a[2], a[3]); w.z = cvt_pk(b[0], b[1]); w.w = cvt_pk(b[2], b[3]); *(u32x4*)p = w; }
    __device__ __forceinline__ void operator()(const f32x4 (&acc)[2][2][4][2], const Unit& u, int wr, int wc, int fr, int fq) const {
        const int pn = u.pn; const bool rope = (pn < 12), conv = (pn >= 24 && pn < 48);
        const int row0 = u.pm * BM + wr * 64 + fr, dh0 = 32 * (wc & 1) + 8 * fq;
        bf16_t* base = O + (size_t)row0 * NIN + pn * BM + 128 * (wc >> 1) + dh0;
#pragma unroll
        for (int ai = 0; ai < 2; ++ai)
#pragma unroll
            for (int m = 0; m < 4; ++m) { bf16_t* rowp = base + (size_t)(ai * HALF + m * 16) * NIN;
                if (rope) { const int pos = (row0 + ai * HALF + m * 16) & (SEQ - 1); const float* cp = c128 + pos * 64 + dh0; const float* sp = s128 + pos * 64 + dh0;
                    const f32x4 c0 = *(const f32x4*)cp, c1 = *(const f32x4*)(cp + 4), s0 = *(const f32x4*)sp, s1 = *(const f32x4*)(sp + 4);
                    const f32x4 a0 = acc[ai][0][m][0], a1 = acc[ai][0][m][1], b0 = acc[ai][1][m][0], b1 = acc[ai][1][m][1];
                    st16(rowp, a0 * c0 - b0 * s0, a1 * c1 - b1 * s1); st16(rowp + 64, b0 * c0 + a0 * s0, b1 * c1 + a1 * s1);
                } else if (conv) {
                    const f32x4 a0 = acc[ai][0][m][0], a1 = acc[ai][0][m][1], b0 = acc[ai][1][m][0], b1 = acc[ai][1][m][1]; f32x4 r0, r1;
                    if (wc < 2) { r0 = a0 * b0; r1 = a1 * b1; }
                    else {
#pragma unroll
                        for (int e = 0; e < 4; ++e) { r0[e] = a0[e] * silu_f(b0[e]); r1[e] = a1[e] * silu_f(b1[e]); } }
                    st16(O + (size_t)(row0 + ai * HALF + m * 16) * NIN + ((wc < 2) ? UC : BC) + (pn - 24) * 64 + dh0, r0, r1);
                } else { st16(rowp, acc[ai][0][m][0], acc[ai][0][m][1]); st16(rowp + 64, acc[ai][1][m][0], acc[ai][1][m][1]); } }
    }
};
struct EpiMem {
    static constexpr int PERM = 1;
    bf16_t* MKo; bf16_t* MVo;
    static __device__ __forceinline__ void st16(bf16_t* p, const f32x4 a, const f32x4 b) { u32x4 w; w.x = cvt_pk(a[0], a[1]); w.y = cvt_pk(a[2], a[3]); w.z = cvt_pk(b[0], b[1]); w.w = cvt_pk(b[2], b[3]); *(u32x4*)p = w; }
    __device__ __forceinline__ void operator()(const f32x4 (&acc)[2][2][4][2], const Unit& u, int wr, int wc, int fr, int fq) const {
        const int row0 = u.pm * BM + wr * 64 + fr, dh0 = 32 * wc + 8 * fq;
        bf16_t* base = ((u.pn < 4) ? MKo + u.pn * 256 : MVo + (u.pn - 4) * 256) + (size_t)row0 * 1024 + dh0;
#pragma unroll
        for (int ai = 0; ai < 2; ++ai)
#pragma unroll
            for (int m = 0; m < 4; ++m) { bf16_t* rowp = base + (size_t)(ai * HALF + m * 16) * 1024; st16(rowp, acc[ai][0][m][0], acc[ai][0][m][1]); st16(rowp + HALF, acc[ai][1][m][0], acc[ai][1][m][1]); }
    }
};
struct EpiY2 {
    static constexpr int PERM = 0;
    float* O; float* ssq;
    __device__ __forceinline__ void operator()(const f32x4 (&acc)[2][2][4][2], const Unit& u, int wr, int wc, int fr, int fq) const {
        const int row0 = u.pm * BM + wr * 64 + fr, col0 = u.pn * BM + wc * 32 + 4 * fq;
#pragma unroll
        for (int ai = 0; ai < 2; ++ai)
#pragma unroll
            for (int m = 0; m < 4; ++m) { const int row = row0 + ai * HALF + m * 16; float* rowp = O + (size_t)row * D + col0; float s = 0.f;
#pragma unroll
                for (int bj = 0; bj < 2; ++bj)
#pragma unroll
                    for (int n = 0; n < 2; ++n) { const f32x4 v = acc[ai][bj][m][n]; *(f32x4*)(rowp + bj * HALF + 16 * n) = v; s += (v[0] * v[0] + v[1] * v[1]) + (v[2] * v[2] + v[3] * v[3]); }
                s += __shfl_xor(s, 16); s += __shfl_xor(s, 32);
                if (fq == 0) ssq[(size_t)row * 64 + u.pn * 4 + wc] = s; }
    }
};

struct EpiOut {
    static constexpr int PERM = 0;
    const float* x; const float* gain; float* out; float* ssqt; unsigned* cnt;
    __device__ __forceinline__ void operator()(const f32x4 (&acc)[2][2][4][2], const Unit& u, int wr, int wc, int fr, int fq) const {
        const int row0 = u.pm * BM + wr * 64 + fr, col0 = u.pn * BM + wc * 32 + 4 * fq;
#pragma unroll
        for (int ai = 0; ai < 2; ++ai)
#pragma unroll
            for (int m = 0; m < 4; ++m) { const int row = row0 + ai * HALF + m * 16; float s = 0.f;
#pragma unroll
                for (int bj = 0; bj < 2; ++bj)
#pragma unroll
                    for (int n = 0; n < 2; ++n) { const f32x4 v = acc[ai][bj][m][n]; s += (v[0] * v[0] + v[1] * v[1]) + (v[2] * v[2] + v[3] * v[3]); }
                s += __shfl_xor(s, 16); s += __shfl_xor(s, 32);
                if (fq == 0) (void)__hip_atomic_fetch_add(ssqt + row, s, __ATOMIC_RELAXED, __HIP_MEMORY_SCOPE_AGENT); }
        f32x4 gg[2][2];
#pragma unroll
        for (int bj = 0; bj < 2; ++bj)
#pragma unroll
            for (int n = 0; n < 2; ++n) gg[bj][n] = *(const f32x4*)(gain + col0 + bj * HALF + 16 * n);
        f32x4 xv[2][2][2];
#pragma unroll
        for (int g = 0; g < 2; ++g) { const float* xr = x + (size_t)(row0 + g * 16) * D + col0;
#pragma unroll
            for (int bj = 0; bj < 2; ++bj)
#pragma unroll
                for (int n = 0; n < 2; ++n) xv[g][bj][n] = __builtin_nontemporal_load((const f32x4*)(xr + bj * HALF + 16 * n)); }
        asm volatile("s_waitcnt vmcnt(0)" ::: "memory");
        __builtin_amdgcn_s_barrier();
        if (wr == 0 && wc == 0) {
            unsigned* c = cnt + 64 * u.pm;
            if (fr == 0 && fq == 0) __hip_atomic_fetch_add(c, 1u, __ATOMIC_RELAXED, __HIP_MEMORY_SCOPE_AGENT);
            unsigned sp = 0; while ((unsigned)__builtin_amdgcn_readfirstlane(__hip_atomic_load(c, __ATOMIC_RELAXED, __HIP_MEMORY_SCOPE_AGENT)) < 16u) { __builtin_amdgcn_s_sleep(2); if (++sp > (1u << 24)) break; }
        }
        __builtin_amdgcn_s_barrier();
        asm volatile("" ::: "memory");
        float tot[8];
#pragma unroll
        for (int g = 0; g < 8; ++g) tot[g] = __hip_atomic_load(ssqt + row0 + (g >> 2) * HALF + (g & 3) * 16, __ATOMIC_RELAXED, __HIP_MEMORY_SCOPE_AGENT);
#pragma unroll
        for (int g = 0; g < 8; ++g) { const int ai = g >> 2, m = g & 3; const int row = row0 + ai * HALF + m * 16;
            const float rs = 1.0f / sqrtf(tot[g] * (1.0f / D) + EPS);
            float* orow = out + (size_t)row * D + col0;
#pragma unroll
            for (int bj = 0; bj < 2; ++bj)
#pragma unroll
                for (int n = 0; n < 2; ++n) *(f32x4*)(orow + bj * HALF + 16 * n) = xv[g & 1][bj][n] + acc[ai][bj][m][n] * rs * gg[bj][n];
            if (g + 2 < 8) { const int g2 = g + 2; const float* xr = x + (size_t)(row0 + (g2 >> 2) * HALF + (g2 & 3) * 16) * D + col0;
#pragma unroll
                for (int bj = 0; bj < 2; ++bj)
#pragma unroll
                    for (int n = 0; n < 2; ++n) xv[g & 1][bj][n] = __builtin_nontemporal_load((const f32x4*)(xr + bj * HALF + 16 * n)); } }
    }
};
struct PanelOrder {
    int c;
    __host__ __device__ bool next(int i, Unit& u) const { if (i >= 2) return false; const int xx = c & 7, k = c >> 3; u.pm = 16 * i + 4 * (xx >> 1) + (k & 3); u.pn = 8 * (xx & 1) + (k >> 2); u.ks = 0; return true; }
};

template <class Epi, class Sched, bool ALIGN_EPI = true>
__device__ __forceinline__ void gemm_phase(LAS unsigned char* lds, const Gemm g, const Sched& S, const Epi& E) {
    const int tid = threadIdx.x, wid = __builtin_amdgcn_readfirstlane(tid >> 6), lane = tid & 63, wr = wid >> 2, wc = wid & 3, fr = lane & 15, fq = lane >> 4;
    const int K = g.ld, nt = g.kloop / BK;
    unsigned voffA[2], voffB[2];
#pragma unroll
    for (int i = 0; i < 2; ++i) { int R, C; stage_rc(tid * 16 + i * 8192, R, C); const int Rb = (Epi::PERM == 1) ? ((R & ~31) + perm32(R & 31)) : ((Epi::PERM == 2) ? perm_rope(R) : ((Epi::PERM == 3) ? perm_wide(R, 0) : R));
        voffA[i] = (unsigned)(R * K + C) * 2u; voffB[i] = (unsigned)(Rb * K + C) * 2u; }
    const size_t h1step = (size_t)((Epi::PERM == 3) ? 64 : HALF) * K * 2;
    const size_t kstep = (size_t)(BK * 2);
    const size_t hstep = (size_t)HALF * K * 2;
    const size_t tstep = 2 * hstep;
    const size_t ksplit = (size_t)g.kloop * 2;
    const unsigned ldsw = (unsigned)wid * 1024u;
    const int aoff = lds_byte(wr * 64 + fr, fq * 8), boff = lds_byte(wc * 32 + fr, fq * 8);
#define PG8_SA(b, h) (((b) * 2 + (h)) * HTB)
#define PG8_SB(b, h) ((4 + (b) * 2 + (h)) * HTB)
#define PG8_STAGE(bufoff, gbase, voff) do { _Pragma("unroll") for (int _i = 0; _i < 2; ++_i) \
        __builtin_amdgcn_global_load_lds((const unsigned*)((const char*)(gbase) + (voff)[_i]), (LAS unsigned*)(lds + (bufoff) + ldsw + _i * 8192), 16, 0, 0); } while (0)
#define PG8_LDA(dst, b, h) do { _Pragma("unroll") for (int m = 0; m < 4; ++m) _Pragma("unroll") for (int k = 0; k < 2; ++k) dst[m][k] = *(const LAS bf16x8*)(lds + PG8_SA(b, h) + aoff + m * 2048 + k * 1024); } while (0)
#define PG8_LDB(dst, b, h) do { _Pragma("unroll") for (int n = 0; n < 2; ++n) _Pragma("unroll") for (int k = 0; k < 2; ++k) dst[n][k] = *(const LAS bf16x8*)(lds + PG8_SB(b, h) + boff + n * 2048 + k * 1024); } while (0)
#define PG8_MMA(ai, bj, At, Bt) do { __builtin_amdgcn_s_setprio(1); _Pragma("unroll") for (int m = 0; m < 4; ++m) _Pragma("unroll") for (int n = 0; n < 2; ++n) _Pragma("unroll") for (int k = 0; k < 2; ++k) \
        acc[ai][bj][m][n] = __builtin_amdgcn_mfma_f32_16x16x32_bf16(Bt[n][k], At[m][k], acc[ai][bj][m][n], 0, 0, 0); __builtin_amdgcn_s_setprio(0); } while (0)
#define PG8_WAIT_V(n) asm volatile("s_waitcnt vmcnt(" #n ")" ::: "memory")
#define PG8_WAIT_L(n) asm volatile("s_waitcnt lgkmcnt(" #n ")" ::: "memory")
#define PG8_BAR __builtin_amdgcn_s_barrier()
#define PG8_SCHED __builtin_amdgcn_sched_barrier(0)
    Unit cur, nxt; int ui = 0;
    if (!S.next(0, cur)) return;
    f32x4 acc[2][2][4][2];
#pragma unroll
    for (int a = 0; a < 2; ++a)
#pragma unroll
        for (int b = 0; b < 2; ++b)
#pragma unroll
            for (int m = 0; m < 4; ++m)
#pragma unroll
                for (int n = 0; n < 2; ++n) acc[a][b][m][n] = (f32x4){0.f, 0.f, 0.f, 0.f};
    bf16x8 At[4][2], B0[2][2], B1[2][2];
    const char* cA = (const char*)g.A + (size_t)cur.pm * tstep + (size_t)cur.ks * ksplit; const char* cB = (const char*)g.Bt + (size_t)cur.pn * tstep + (size_t)cur.ks * ksplit;
    PG8_STAGE(PG8_SB(0, 0), cB, voffB); PG8_STAGE(PG8_SB(0, 1), cB + h1step, voffB); PG8_STAGE(PG8_SA(0, 0), cA, voffA); PG8_STAGE(PG8_SA(0, 1), cA + hstep, voffA);
    if (wr == 1) PG8_BAR;
    PG8_WAIT_V(2); PG8_BAR;
    PG8_STAGE(PG8_SB(1, 0), cB + kstep, voffB); PG8_STAGE(PG8_SA(1, 0), cA + kstep, voffA); PG8_STAGE(PG8_SB(1, 1), cB + h1step + kstep, voffB);
    PG8_WAIT_V(6); PG8_BAR;
    for (;;) {
        const bool has_next = S.next(ui + 1, nxt);
        const char* nA = has_next ? (const char*)g.A + (size_t)nxt.pm * tstep + (size_t)nxt.ks * ksplit : cA; const char* nB = has_next ? (const char*)g.Bt + (size_t)nxt.pn * tstep + (size_t)nxt.ks * ksplit : cB;
        for (int t = 0; t < nt; t += 2) {
            const bool last = (t == nt - 2);
            const char* a1 = cA + (size_t)(t + 1) * kstep;
            const char* a2 = last ? nA : cA + (size_t)(t + 2) * kstep; const char* b2 = last ? nB : cB + (size_t)(t + 2) * kstep;
            const char* a3 = a2 + kstep; const char* b3 = b2 + kstep;
            PG8_LDB(B0, 0, 0); PG8_LDB(B1, 0, 1); PG8_SCHED; PG8_LDA(At, 0, 0); PG8_STAGE(PG8_SA(1, 1), a1 + hstep, voffA);
            PG8_WAIT_V(8); PG8_WAIT_L(0); PG8_BAR; PG8_MMA(0, 0, At, B0); PG8_MMA(0, 1, At, B1); PG8_BAR; PG8_SCHED;
            PG8_LDA(At, 0, 1); PG8_STAGE(PG8_SB(0, 0), b2, voffB); PG8_STAGE(PG8_SB(0, 1), b2 + h1step, voffB); PG8_STAGE(PG8_SA(0, 0), a2, voffA);
            PG8_WAIT_V(8); PG8_WAIT_L(0); PG8_BAR; PG8_MMA(1, 0, At, B0); PG8_MMA(1, 1, At, B1); PG8_BAR; PG8_SCHED;
            PG8_LDB(B0, 1, 0); PG8_LDB(B1, 1, 1); PG8_SCHED; PG8_LDA(At, 1, 0); PG8_STAGE(PG8_SA(0, 1), a2 + hstep, voffA);
            PG8_WAIT_V(8); PG8_WAIT_L(0); PG8_BAR; PG8_MMA(0, 0, At, B0); PG8_MMA(0, 1, At, B1); PG8_BAR; PG8_SCHED;
            PG8_LDA(At, 1, 1); PG8_STAGE(PG8_SB(1, 0), b3, voffB); PG8_STAGE(PG8_SB(1, 1), b3 + h1step, voffB); PG8_STAGE(PG8_SA(1, 0), a3, voffA);
            PG8_WAIT_V(8); PG8_WAIT_L(0); PG8_BAR; PG8_MMA(1, 0, At, B0); PG8_MMA(1, 1, At, B1); PG8_BAR; PG8_SCHED;
        }
        if constexpr (ALIGN_EPI) { if (wr == 0) PG8_BAR; }
        E(acc, cur, wr, wc, fr, fq);
        if (!has_next) break;
#pragma unroll
        for (int a = 0; a < 2; ++a)
#pragma unroll
            for (int b = 0; b < 2; ++b)
#pragma unroll
                for (int m = 0; m < 4; ++m)
#pragma unroll
                    for (int n = 0; n < 2; ++n) acc[a][b][m][n] = (f32x4){0.f, 0.f, 0.f, 0.f};
        cur = nxt; cA = nA; cB = nB; ++ui;
        if constexpr (ALIGN_EPI) { if (wr == 1) PG8_BAR; }
    }
    PG8_WAIT_V(0);
    if constexpr (!ALIGN_EPI) { if (wr == 0) PG8_BAR; }
    PG8_BAR;
#undef PG8_SA
#undef PG8_SB
#undef PG8_STAGE
#undef PG8_LDA
#undef PG8_LDB
#undef PG8_MMA
#undef PG8_WAIT_V
#undef PG8_WAIT_L
#undef PG8_BAR
#undef PG8_SCHED
}
}

__host__ __device__ __forceinline__ int win_row_of_col64(int c) {
    if (c < UC || c >= QX) return c;
    const int sec = (c - UC) / 1536, ch = (c - UC) - sec * 1536;
    const int grp = (sec == 0) ? 0 : ((sec == 2) ? 1 : ((sec == 1) ? 2 : 3));
    return UC + (ch >> 6) * 256 + grp * 64 + (ch & 63);
}
__device__ __forceinline__ void transpose_item(const float* __restrict__ W, int K, int N, bf16_t* __restrict__ WT, LAS float* scr, int item, int lane, bool regroup = false) {
    const int nblk = N >> 6, kb = item / nblk, nb = item - kb * nblk, k0 = kb << 6, n0 = nb << 6;
    const int l16 = lane & 15, l4 = lane >> 4;
    f32x4 v[16];
#pragma unroll
    for (int i = 0; i < 16; ++i) v[i] = __builtin_nontemporal_load((const f32x4*)(W + (size_t)(k0 + 4 * i + l4) * N + n0 + 4 * l16));
#pragma unroll
    for (int i = 0; i < 16; ++i) { LAS float* d = scr + (4 * i + l4) * 65 + 4 * l16; d[0] = v[i][0]; d[1] = v[i][1]; d[2] = v[i][2]; d[3] = v[i][3]; }
    asm volatile("s_waitcnt lgkmcnt(0)" ::: "memory");
    const int c = lane & 7, nr = lane >> 3;
#pragma unroll
    for (int j = 0; j < 8; ++j) { const int n = nr + 8 * j; const LAS float* s = scr + (8 * c) * 65 + n;
        u32x4 o; o.x = cvt_pk(s[0], s[65]); o.y = cvt_pk(s[2 * 65], s[3 * 65]); o.z = cvt_pk(s[4 * 65], s[5 * 65]); o.w = cvt_pk(s[6 * 65], s[7 * 65]);
        *(u32x4*)(WT + (size_t)((regroup ? win_row_of_col64(n0) : n0) + n) * K + k0 + 8 * c) = o; }
    asm volatile("s_waitcnt lgkmcnt(0)" ::: "memory");
}
__device__ __forceinline__ void rms_row_to_bf16(const float* __restrict__ xrow, const float* __restrict__ gain, bf16_t* __restrict__ orow, int lane) {
    const f32x4* xr = (const f32x4*)xrow + lane; const f32x4* gr = (const f32x4*)gain + lane;
    f32x4 v[16]; float s = 0.f;
#pragma unroll
    for (int j = 0; j < 16; ++j) { v[j] = __builtin_nontemporal_load(xr + 64 * j); s += (v[j][0] * v[j][0] + v[j][1] * v[j][1]) + (v[j][2] * v[j][2] + v[j][3] * v[j][3]); }
    const float rs = 1.0f / sqrtf(wave_sum(s) * (1.0f / D) + EPS);
    u32x2* o8 = (u32x2*)orow + lane;
#pragma unroll
    for (int j = 0; j < 16; ++j) { const f32x4 gg = gr[64 * j]; u32x2 w; w.x = cvt_pk(v[j][0] * rs * gg[0], v[j][1] * rs * gg[1]); w.y = cvt_pk(v[j][2] * rs * gg[2], v[j][3] * rs * gg[3]); o8[64 * j] = w; }
}


__device__ __forceinline__ void rms_load(f32x4 (&v)[16], const float* __restrict__ xrow, int lane) {
    const f32x4* xr = (const f32x4*)xrow + lane;
#pragma unroll
    for (int j = 0; j < 16; ++j) v[j] = __builtin_nontemporal_load(xr + 64 * j);
}
__device__ __forceinline__ void rms_finish(const f32x4 (&v)[16], const float* __restrict__ gain, bf16_t* __restrict__ orow, int lane) {
    const f32x4* gr = (const f32x4*)gain + lane; float s = 0.f;
#pragma unroll
    for (int j = 0; j < 16; ++j) s += (v[j][0] * v[j][0] + v[j][1] * v[j][1]) + (v[j][2] * v[j][2] + v[j][3] * v[j][3]);
    const float rs = 1.0f / sqrtf(wave_sum(s) * (1.0f / D) + EPS);
    u32x2* o8 = (u32x2*)orow + lane;
#pragma unroll
    for (int j = 0; j < 16; ++j) { const f32x4 gg = gr[64 * j]; u32x2 w; w.x = cvt_pk(v[j][0] * rs * gg[0], v[j][1] * rs * gg[1]); w.y = cvt_pk(v[j][2] * rs * gg[2], v[j][3] * rs * gg[3]); o8[64 * j] = w; }
}

typedef short v4i16_t __attribute__((ext_vector_type(4)));
__device__ __forceinline__ s16x4 vtr(const LAS unsigned char* p) { return __builtin_bit_cast(s16x4, __builtin_amdgcn_ds_read_tr16_b64_v4i16((LAS v4i16_t*)p)); }
__device__ __forceinline__ bf16x8 cat8(s16x4 lo, s16x4 hi) { return (bf16x8){lo[0], lo[1], lo[2], lo[3], hi[0], hi[1], hi[2], hi[3]}; }
__device__ __forceinline__ bf16x8 pk8(u32x2 a, u32x2 b) { u32x4 t; t.x = a.x; t.y = a.y; t.z = b.x; t.w = b.y; return __builtin_bit_cast(bf16x8, t); }

constexpr int AK_STRIDE = 272, AV_STRIDE = 288, AV_OFF = 256 * AK_STRIDE;
__device__ __forceinline__ void attnA_unit(LAS unsigned char* lds, const bf16_t* __restrict__ PROJ, bf16_t* __restrict__ OA, float* __restrict__ LSE, int uidx) {
    const int tid = threadIdx.x, lane = tid & 63, wid = __builtin_amdgcn_readfirstlane(tid >> 6), fr = lane & 15, fq = lane >> 4;
    const int b = uidx / 192, rem = uidx - b * 192, h = rem >> 4, k16 = rem & 15, g = h >> 2, sh = 2 * g, d = 1 << sh, nbk = 16 >> sh;
    const int r = k16 >> (4 - sh), n = k16 & (nbk - 1);
    const size_t rowbase = (size_t)b * SEQ + r;
    LAS unsigned char* Ks = lds; LAS unsigned char* Vs = lds + AV_OFF;
    {
        u32x4 kv[8], vv[8];
#pragma unroll
        for (int it = 0; it < 8; ++it) { const int id = tid + 512 * it, kk = id >> 4, c = id & 15; int i = 128 * (n - 1) + kk; i = i < 0 ? 0 : i;
            const bf16_t* src = PROJ + (rowbase + (size_t)i * d) * NIN + h * 128 + c * 8; kv[it] = *(const u32x4*)(src + KA); vv[it] = *(const u32x4*)(src + VA); }
#pragma unroll
        for (int it = 0; it < 8; ++it) { const int id = tid + 512 * it, kk = id >> 4, c = id & 15; *(LAS u32x4*)(Ks + kk * AK_STRIDE + c * 16) = kv[it]; *(LAS u32x4*)(Vs + kk * AV_STRIDE + c * 16) = vv[it]; }
    }
    const size_t qrow = rowbase + (size_t)(128 * n + 16 * wid + fr) * d;
    bf16x8 qf[4];
#pragma unroll
    for (int kk = 0; kk < 4; ++kk) qf[kk] = *(const bf16x8*)(PROJ + qrow * NIN + QA + h * 128 + 32 * kk + 8 * fq);
    __syncthreads();
    const bool firstblk = (n == 0);
    f32x4 st[9];
#pragma unroll
    for (int j = 0; j < 9; ++j) { st[j] = (f32x4){0.f, 0.f, 0.f, 0.f}; const int kt = wid + j;
        if (!(firstblk && kt < 8)) {
#pragma unroll
            for (int kk = 0; kk < 4; ++kk) { const bf16x8 a = *(const LAS bf16x8*)(Ks + (16 * kt + fr) * AK_STRIDE + (32 * kk + 8 * fq) * 2); st[j] = __builtin_amdgcn_mfma_f32_16x16x32_bf16(a, qf[kk], st[j], 0, 0, 0); }
        } }
    const float sc = 0.08838834764831845f * LOG2E; float mx = -INFINITY;
#pragma unroll
    for (int j = 0; j < 9; ++j)
#pragma unroll
        for (int jj = 0; jj < 4; ++jj) { const int kl = 4 * fq + jj; bool valid = !(firstblk && (wid + j) < 8); if (j == 0) valid = valid && (kl >= fr); if (j == 8) valid = valid && (kl <= fr);
            const float s = valid ? st[j][jj] * sc : -INFINITY; st[j][jj] = s; mx = fmaxf(mx, s); }
    mx = fmaxf(mx, __shfl_xor(mx, 16)); mx = fmaxf(mx, __shfl_xor(mx, 32));
    float l = 0.f; u32x2 pk[9];
#pragma unroll
    for (int j = 0; j < 9; ++j) { float p[4];
#pragma unroll
        for (int jj = 0; jj < 4; ++jj) { p[jj] = __builtin_amdgcn_exp2f(st[j][jj] - mx); l += p[jj]; }
        pk[j].x = cvt_pk(p[0], p[1]); pk[j].y = cvt_pk(p[2], p[3]); }
    l += __shfl_xor(l, 16); l += __shfl_xor(l, 32);
    f32x4 o[8];
    const LAS unsigned char* vbase = Vs + (16 * wid + 4 * fq + ((lane >> 2) & 3)) * AV_STRIDE + (lane & 3) * 8;
    const u32x2 zz = (u32x2){0u, 0u};
#pragma unroll
    for (int dt = 0; dt < 8; ++dt) { o[dt] = (f32x4){0.f, 0.f, 0.f, 0.f};
#pragma unroll
        for (int p = 0; p < 5; ++p) { const int jA = 2 * p, jB = (p < 4) ? 2 * p + 1 : 8;
            const s16x4 lo = vtr(vbase + 16 * jA * AV_STRIDE + dt * 32), hi = vtr(vbase + 16 * jB * AV_STRIDE + dt * 32);
            o[dt] = __builtin_amdgcn_mfma_f32_16x16x32_bf16(cat8(lo, hi), pk8(pk[jA], (p < 4) ? pk[jB] : zz), o[dt], 0, 0, 0); } }
    const float rl = 1.0f / l;
    bf16_t* op = OA + qrow * 1536 + h * 128 + 4 * fq;
#pragma unroll
    for (int dt = 0; dt < 8; ++dt) { u32x2 w; w.x = cvt_pk(o[dt][0] * rl, o[dt][1] * rl); w.y = cvt_pk(o[dt][2] * rl, o[dt][3] * rl); *(u32x2*)(op + 16 * dt) = w; }
    if (fq == 0) LSE[qrow * 12 + h] = (mx + __builtin_amdgcn_logf(l)) * LN2;
    __syncthreads();
}

constexpr int XK_STRIDE = 528, XV_STRIDE = 544;
__device__ __forceinline__ void attnX_unit(LAS unsigned char* lds, const bf16_t* __restrict__ PROJ, const bf16_t* __restrict__ MK, const bf16_t* __restrict__ MV, bf16_t* __restrict__ Y, const float* __restrict__ C256, const float* __restrict__ S256, int uidx) {
    const int tid = threadIdx.x, lane = tid & 63, wid = __builtin_amdgcn_readfirstlane(tid >> 6), fr = lane & 15, fq = lane >> 4;
    const int b = uidx >> 6, hx = (uidx >> 4) & 3, qb = uidx & 15;
    const size_t qrow = (size_t)b * SEQ + qb * 128 + 16 * wid + fr;
    const bf16_t* kbase = MK + (size_t)b * MEML * 1024 + hx * 256; const bf16_t* vbase_g = MV + (size_t)b * MEML * 1024 + hx * 256;
    bf16x8 qf[8];
#pragma unroll
    for (int kk = 0; kk < 8; ++kk) qf[kk] = *(const bf16x8*)(PROJ + qrow * NIN + QX + hx * 256 + 32 * kk + 8 * fq);
    {
        const int pos = ((int)qrow & (SEQ - 1)) + MEML;
#pragma unroll
        for (int kk = 0; kk < 4; ++kk) { const float* cp = C256 + pos * 128 + 32 * kk + 8 * fq; const float* sp = S256 + pos * 128 + 32 * kk + 8 * fq;
            const f32x4 c0 = *(const f32x4*)cp, c1 = *(const f32x4*)(cp + 4), s0 = *(const f32x4*)sp, s1 = *(const f32x4*)(sp + 4);
            const u32x4 xa = __builtin_bit_cast(u32x4, qf[kk]), xb = __builtin_bit_cast(u32x4, qf[kk + 4]); u32x4 ya, yb;
#pragma unroll
            for (int q = 0; q < 4; ++q) { const float cl = (q < 2) ? c0[2 * q] : c1[2 * q - 4], ch = (q < 2) ? c0[2 * q + 1] : c1[2 * q - 3], sl = (q < 2) ? s0[2 * q] : s1[2 * q - 4], sh = (q < 2) ? s0[2 * q + 1] : s1[2 * q - 3];
                const float a_l = bf_lo(xa[q]), a_h = bf_hi(xa[q]), b_l = bf_lo(xb[q]), b_h = bf_hi(xb[q]);
                ya[q] = cvt_pk(a_l * cl - b_l * sl, a_h * ch - b_h * sh); yb[q] = cvt_pk(b_l * cl + a_l * sl, b_h * ch + a_h * sh); }
            qf[kk] = __builtin_bit_cast(bf16x8, ya); qf[kk + 4] = __builtin_bit_cast(bf16x8, yb); }
    }
    __builtin_amdgcn_sched_barrier(0);
    {
#pragma unroll 2
        for (int it = 0; it < 8; ++it) { const int id = tid + 512 * it, kk = id >> 4, c = id & 15;
            const u32x4 xa = *(const u32x4*)(kbase + (size_t)kk * 1024 + c * 8), xb = *(const u32x4*)(kbase + (size_t)kk * 1024 + 128 + c * 8);
            const float* cp = C256 + kk * 128 + c * 8; const float* sp = S256 + kk * 128 + c * 8;
            const f32x4 c0 = *(const f32x4*)cp, c1 = *(const f32x4*)(cp + 4), s0 = *(const f32x4*)sp, s1 = *(const f32x4*)(sp + 4);
            u32x4 ya, yb;
#pragma unroll
            for (int q = 0; q < 4; ++q) { const float cl = (q < 2) ? c0[2 * q] : c1[2 * q - 4], ch = (q < 2) ? c0[2 * q + 1] : c1[2 * q - 3], sl = (q < 2) ? s0[2 * q] : s1[2 * q - 4], sh = (q < 2) ? s0[2 * q + 1] : s1[2 * q - 3];
                const float a_l = bf_lo(xa[q]), a_h = bf_hi(xa[q]), b_l = bf_lo(xb[q]), b_h = bf_hi(xb[q]);
                ya[q] = cvt_pk(a_l * cl - b_l * sl, a_h * ch - b_h * sh); yb[q] = cvt_pk(b_l * cl + a_l * sl, b_h * ch + a_h * sh); }
            *(LAS u32x4*)(lds + kk * XK_STRIDE + c * 16) = ya; *(LAS u32x4*)(lds + kk * XK_STRIDE + 256 + c * 16) = yb; }
    }
    __syncthreads();
    f32x4 st[16];
#pragma unroll
    for (int j = 0; j < 16; ++j) { st[j] = (f32x4){0.f, 0.f, 0.f, 0.f};
#pragma unroll
        for (int kk = 0; kk < 8; ++kk) { const bf16x8 a = *(const LAS bf16x8*)(lds + (16 * j + fr) * XK_STRIDE + (32 * kk + 8 * fq) * 2); st[j] = __builtin_amdgcn_mfma_f32_16x16x32_bf16(a, qf[kk], st[j], 0, 0, 0); } }
    const float sc = 0.0625f * LOG2E; float mx = -INFINITY;
#pragma unroll
    for (int j = 0; j < 16; ++j)
#pragma unroll
        for (int jj = 0; jj < 4; ++jj) { const float s = st[j][jj] * sc; st[j][jj] = s; mx = fmaxf(mx, s); }
    mx = fmaxf(mx, __shfl_xor(mx, 16)); mx = fmaxf(mx, __shfl_xor(mx, 32));
    float l = 0.f; u32x2 pk[16];
#pragma unroll
    for (int j = 0; j < 16; ++j) { float p[4];
#pragma unroll
        for (int jj = 0; jj < 4; ++jj) { p[jj] = __builtin_amdgcn_exp2f(st[j][jj] - mx); l += p[jj]; }
        pk[j].x = cvt_pk(p[0], p[1]); pk[j].y = cvt_pk(p[2], p[3]); }
    l += __shfl_xor(l, 16); l += __shfl_xor(l, 32);
    __syncthreads();
    {
#pragma unroll
        for (int hf = 0; hf < 2; ++hf) { u32x4 vv[8];
#pragma unroll
            for (int it = 0; it < 8; ++it) { const int id = tid + 512 * (it + 8 * hf), kk = id >> 5, c = id & 31; vv[it] = *(const u32x4*)(vbase_g + (size_t)kk * 1024 + c * 8); }
#pragma unroll
            for (int it = 0; it < 8; ++it) { const int id = tid + 512 * (it + 8 * hf), kk = id >> 5, c = id & 31; *(LAS u32x4*)(lds + kk * XV_STRIDE + c * 16) = vv[it]; } }
    }
    __syncthreads();
    const LAS unsigned char* vb = lds + (4 * fq + ((lane >> 2) & 3)) * XV_STRIDE + (lane & 3) * 8;
    const float rl = 1.0f / l;
    const bf16_t* zp = PROJ + qrow * NIN + ZX + hx * 256 + 4 * fq;
    bf16_t* yp = Y + qrow * D + 3072 + hx * 256 + 4 * fq;
#pragma unroll
    for (int dt = 0; dt < 16; ++dt) { f32x4 o = (f32x4){0.f, 0.f, 0.f, 0.f};
#pragma unroll
        for (int p = 0; p < 8; ++p) { const s16x4 lo = vtr(vb + 16 * (2 * p) * XV_STRIDE + dt * 32), hi = vtr(vb + 16 * (2 * p + 1) * XV_STRIDE + dt * 32);
            o = __builtin_amdgcn_mfma_f32_16x16x32_bf16(cat8(lo, hi), pk8(pk[2 * p], pk[2 * p + 1]), o, 0, 0, 0); }
        const u32x2 zw = *(const u32x2*)(zp + 16 * dt);
        u32x2 w; w.x = cvt_pk(o[0] * rl * silu_f(bf_lo(zw.x)), o[1] * rl * silu_f(bf_hi(zw.x))); w.y = cvt_pk(o[2] * rl * silu_f(bf_lo(zw.y)), o[3] * rl * silu_f(bf_hi(zw.y)));
        *(u32x2*)(yp + 16 * dt) = w; }
    __syncthreads();
}


#define XB_TMO      128
#define XB_XCNT(j)  (256  + 64 * (j))
#define XB_XSUB(j)  (1280 + 64 * (j))
#define XB_XGEN(j)  (2304 + 64 * (j))
#define XB_TOP      3328
#define XB_TOPGEN   3392
#define XCD_BAR_WORDS 3456
#define XB_SPIN_CAP (1u << 22)
__device__ __forceinline__ unsigned xb_ld(unsigned* p)              { return __hip_atomic_load(p, __ATOMIC_RELAXED, __HIP_MEMORY_SCOPE_AGENT); }
__device__ __forceinline__ unsigned xb_add(unsigned* p, unsigned v) { return __hip_atomic_fetch_add(p, v, __ATOMIC_RELAXED, __HIP_MEMORY_SCOPE_AGENT); }
__device__ __forceinline__ unsigned xb_xcc_id() { return (unsigned)__builtin_amdgcn_s_getreg((3 << 11) | 20) & 0xFu; }
#define XB_SPIN(cond, bar) do { unsigned _sp = 0; while (cond) { __builtin_amdgcn_s_sleep(1); \
    if ((++_sp & 255u) == 0u) { if (xb_ld(&(bar)[XB_TMO])) break; if (_sp > XB_SPIN_CAP) { atomicAdd(&(bar)[XB_TMO], 1u); break; } } } } while (0)
struct XcdBarrier { unsigned* bar; unsigned x; volatile LAS unsigned* st; };
__device__ __forceinline__ XcdBarrier xcd_barrier_post(unsigned* bar, volatile LAS unsigned* st) {
    XcdBarrier b; b.bar = bar; b.x = xb_xcc_id(); b.st = st;
    if (threadIdx.x == 0) (void)xb_add(&bar[XB_XCNT(b.x)], 1u);
    return b;
}
__device__ __forceinline__ void xcd_barrier_complete(unsigned* bar, unsigned x, unsigned& nloc, unsigned& nx) {
    const unsigned G = gridDim.x * gridDim.y * gridDim.z;
    unsigned sum, cnt, mine, sp = 0u;
    for (;;) {
        sum = 0u; cnt = 0u; mine = 0u;
#pragma unroll
        for (unsigned j = 0; j < 16; ++j) { const unsigned c = xb_ld(&bar[XB_XCNT(j)]); sum += c; cnt += (c > 0u) ? 1u : 0u; mine = (j == x) ? c : mine; }
        if (sum == G) break;
        __builtin_amdgcn_s_sleep(1);
        if ((++sp & 255u) == 0u) { if (xb_ld(&bar[XB_TMO])) break; if (sp > XB_SPIN_CAP) { atomicAdd(&bar[XB_TMO], 1u); break; } }
    }
    nloc = mine > 0u ? mine : 1u; nx = cnt > 0u ? cnt : 1u;
}
__device__ __forceinline__ void xcd_barrier(const XcdBarrier& b) {
    asm volatile("s_waitcnt vmcnt(0)" ::: "memory");
    __syncthreads();
    if (threadIdx.x == 0) {
        unsigned* bar = b.bar;
        __builtin_amdgcn_s_waitcnt(0);
        unsigned nloc = b.st[0], nx = b.st[1];
        if (nloc == 0u) { xcd_barrier_complete(bar, b.x, nloc, nx); b.st[0] = nloc; b.st[1] = nx; }
        const unsigned old = xb_add(&bar[XB_XSUB(b.x)], 1u);
        const unsigned gen = old / nloc;
        if (old + 1u == (gen + 1u) * nloc) {
            __builtin_amdgcn_fence(__ATOMIC_RELEASE, "agent");
            asm volatile("s_waitcnt vmcnt(0)" ::: "memory");
            const unsigned og = xb_add(&bar[XB_TOP], 1u);
            const unsigned tg = og / nx;
            if (og + 1u == (tg + 1u) * nx) xb_add(&bar[XB_TOPGEN], 1u);
            else XB_SPIN(xb_ld(&bar[XB_TOPGEN]) == tg, bar);
            __builtin_amdgcn_fence(__ATOMIC_ACQUIRE, "agent");
            xb_add(&bar[XB_XGEN(b.x)], 1u);
            asm volatile("s_waitcnt vmcnt(0)" ::: "memory");
        } else {
            XB_SPIN(xb_ld(&bar[XB_XGEN(b.x)]) == gen, bar);
            __builtin_amdgcn_fence(__ATOMIC_ACQUIRE, "agent");
            asm volatile("s_waitcnt vmcnt(0)" ::: "memory");
        }
    }
    __syncthreads();
}

struct Args { const float* in[9]; float* out; unsigned char* ws; int ph_lo, ph_hi; };

__global__ void __launch_bounds__(512, 2) fwd(Args args) {
    extern __shared__ __attribute__((aligned(16))) unsigned char lds_raw[];
    LAS unsigned char* lds = (LAS unsigned char*)lds_raw;
    cg::grid_group grid = cg::this_grid();
    const int tid = threadIdx.x;
    const int G = gridDim.x, bx = blockIdx.x;
    const float* x = args.in[0]; const float* mem = args.in[1]; const float* pre_norm = args.in[2]; const float* w_in = args.in[3]; const float* conv_w = args.in[4];
    const float* mem_norm = args.in[5]; const float* w_mem_kv = args.in[6]; const float* w_out = args.in[7]; const float* post_norm = args.in[8];
    unsigned char* ws = args.ws;
    bf16_t* WIN = (bf16_t*)(ws + WS_WIN); bf16_t* WOUT = (bf16_t*)(ws + WS_WOUT); bf16_t* WMEM = (bf16_t*)(ws + WS_WMEM);
    bf16_t* H = (bf16_t*)(ws + WS_H); bf16_t* MEMN = (bf16_t*)(ws + WS_MEMN); bf16_t* PROJ = (bf16_t*)(ws + WS_PROJ);
    bf16_t* MK = (bf16_t*)(ws + WS_MK); bf16_t* MV = (bf16_t*)(ws + WS_MV);
    bf16_t* OA = (bf16_t*)(ws + WS_OA); float* LSE = (float*)(ws + WS_LSE); bf16_t* Y = (bf16_t*)(ws + WS_Y);
    float* Y2 = (float*)(ws + WS_Y2); float* SSQ = (float*)(ws + WS_SSQ);
    float* C128 = (float*)(ws + WS_C128); float* S128 = (float*)(ws + WS_S128); float* C256 = (float*)(ws + WS_C256); float* S256 = (float*)(ws + WS_S256);
    const int lo = args.ph_lo, hi = args.ph_hi;
#define IN(k) (lo <= (k) && (k) < hi)
#define GBAR() xcd_barrier(bar)
#define SEAM(k) do { if (IN(k) && IN((k) + 1)) GBAR(); } while (0)
    volatile LAS unsigned* misc = (volatile LAS unsigned*)(lds + MISC_OFF);
    if (tid < 16) misc[tid] = 0u;
    __syncthreads();
    XcdBarrier bar = xcd_barrier_post((unsigned*)(ws + WS_BAR), misc);
    if (args.ph_hi > 1000) grid.sync();
    const int NGW = G * 8, NGT = G * 512;
#define PHASE_IDS() int tid_ = threadIdx.x; asm volatile("" : "+v"(tid_)); const int lane = tid_ & 63, wave = __builtin_amdgcn_readfirstlane(tid_ >> 6), gw = bx * 8 + wave, gt = bx * 512 + tid_; (void)lane; (void)wave; (void)gw; (void)gt
    constexpr int I_IN = (D / 64) * (NIN / 64), I_MEM = (D / 64) * (NKV / 64), I_OUT = (D / 64) * (D / 64);

    if (IN(0)) {
        PHASE_IDS();
        LAS float* scr = (LAS float*)(lds + wave * 16640);
        f32x4 rv[16]; const bool has_row = gw < MM;
        if (has_row) rms_load(rv, mem + (size_t)gw * D, lane);
        for (int e = gt; e < 2048 * 64 + 2304 * 128; e += NGT) {
            const bool a = e < 2048 * 64; const int e2 = a ? e : e - 2048 * 64; const int pos = a ? (e2 >> 6) : (e2 >> 7), i = a ? (e2 & 63) : (e2 & 127);
            const float inv = __builtin_amdgcn_exp2f(-13.287712379549449f * (float)i * (a ? (1.0f / 64.0f) : (1.0f / 128.0f)));
            const float rev = __builtin_amdgcn_fractf((float)pos * inv * 0.15915494309189535f);
            const float c = __builtin_amdgcn_cosf(rev), sn = __builtin_amdgcn_sinf(rev);
            if (a) { C128[e2] = c; S128[e2] = sn; } else { C256[e2] = c; S256[e2] = sn; }
        }
        for (int it = gw; it < I_MEM; it += NGW) transpose_item(w_mem_kv, D, NKV, WMEM, scr, it, lane);
        if (has_row) rms_finish(rv, mem_norm, MEMN + (size_t)gw * D, lane);
        for (int m = gw + NGW; m < MM; m += NGW) rms_row_to_bf16(mem + (size_t)m * D, mem_norm, MEMN + (size_t)m * D, lane);
    }
    SEAM(0);

    if (IN(1)) {
        const bool desig = ((bx >> 3) & 7) == 0;
        const int nd = ((G >> 6) << 3) + (((G & 63) < 8) ? (G & 63) : 8);
        if (desig) { pg8::Gemm g{MEMN, WMEM, D, D}; pg8::MemOrder S{nd, ((bx >> 6) << 3) + (bx & 7)}; pg8::EpiMem E{MK, MV};
            pg8::gemm_phase<pg8::EpiMem, pg8::MemOrder>(lds, g, S, E); }
        else {
            PHASE_IDS();
            LAS float* scr = (LAS float*)(lds + wave * 16640);
            const int gwb = ((bx >> 6) * 56 + (bx & 63) - 8) * 8 + wave, NGWB = (G - nd) * 8;
            for (int it = gwb; it < I_IN + I_OUT; it += NGWB) { if (it < I_IN) transpose_item(w_in, D, NIN, WIN, scr, it, lane, true); else transpose_item(w_out, D, D, WOUT, scr, it - I_IN, lane); }
            for (int m = NGWB - 1 - gwb; m < M; m += NGWB) rms_row_to_bf16(x + (size_t)m * D, pre_norm, H + (size_t)m * D, lane);
        }
    }
    SEAM(1);

    if (IN(2)) { pg8::Gemm g{H, WIN, D, D}; pg8::StaticOrder S; S.init(M, NIN, G, bx); pg8::EpiProj E{PROJ, C128, S128};
        pg8::gemm_phase<pg8::EpiProj, pg8::StaticOrder>(lds, g, S, E); }
    SEAM(2);

    if (IN(3)) {
        const bool attn_first = ((bx >> 3) & 1) == 0;
        if (!attn_first) {
        PHASE_IDS();
        for (int id = gt; id < M * 192; id += NGT) {
            const int row = id / 192, c8 = (id - row * 192) * 8, t = row & (SEQ - 1);
            const bf16_t* pr = PROJ + (size_t)row * NIN + c8;
            const u32x4 p0 = *(const u32x4*)(pr + UC), gg = *(const u32x4*)(pr + BC);
            u32x4 p1 = (u32x4){0u, 0u, 0u, 0u}, p2 = p1;
            if (t >= 1) p1 = *(const u32x4*)(pr - NIN + UC);
            if (t >= 2) p2 = *(const u32x4*)(pr - 2 * NIN + UC);
            float w0[8], w1[8], w2[8];
#pragma unroll
            for (int e = 0; e < 8; ++e) { w0[e] = conv_w[c8 + e]; w1[e] = conv_w[1536 + c8 + e]; w2[e] = conv_w[3072 + c8 + e]; }
            float y[8];
#pragma unroll
            for (int q = 0; q < 4; ++q) {
                y[2 * q] = bf_lo(gg[q]) * (bf_lo(p2[q]) * w0[2 * q] + bf_lo(p1[q]) * w1[2 * q] + bf_lo(p0[q]) * w2[2 * q]);
                y[2 * q + 1] = bf_hi(gg[q]) * (bf_hi(p2[q]) * w0[2 * q + 1] + bf_hi(p1[q]) * w1[2 * q + 1] + bf_hi(p0[q]) * w2[2 * q + 1]);
            }
            u32x4 w; w.x = cvt_pk(y[0], y[1]); w.y = cvt_pk(y[2], y[3]); w.z = cvt_pk(y[4], y[5]); w.w = cvt_pk(y[6], y[7]);
            *(u32x4*)(Y + (size_t)row * D + 1536 + c8) = w;
        }
        }
        for (int u = bx; u < 768; u += G) attnA_unit(lds, PROJ, OA, LSE, u);
        for (int u = bx; u < 256; u += G) attnX_unit(lds, PROJ, MK, MV, Y, C256, S256, u);
        if (attn_first) {
        PHASE_IDS();
        for (int id = gt; id < M * 192; id += NGT) {
            const int row = id / 192, c8 = (id - row * 192) * 8, t = row & (SEQ - 1);
            const bf16_t* pr = PROJ + (size_t)row * NIN + c8;
            const u32x4 p0 = *(const u32x4*)(pr + UC), gg = *(const u32x4*)(pr + BC);
            u32x4 p1 = (u32x4){0u, 0u, 0u, 0u}, p2 = p1;
            if (t >= 1) p1 = *(const u32x4*)(pr - NIN + UC);
            if (t >= 2) p2 = *(const u32x4*)(pr - 2 * NIN + UC);
            float w0[8], w1[8], w2[8];
#pragma unroll
            for (int e = 0; e < 8; ++e) { w0[e] = conv_w[c8 + e]; w1[e] = conv_w[1536 + c8 + e]; w2[e] = conv_w[3072 + c8 + e]; }
            float y[8];
#pragma unroll
            for (int q = 0; q < 4; ++q) {
                y[2 * q] = bf_lo(gg[q]) * (bf_lo(p2[q]) * w0[2 * q] + bf_lo(p1[q]) * w1[2 * q] + bf_lo(p0[q]) * w2[2 * q]);
                y[2 * q + 1] = bf_hi(gg[q]) * (bf_hi(p2[q]) * w0[2 * q + 1] + bf_hi(p1[q]) * w1[2 * q + 1] + bf_hi(p0[q]) * w2[2 * q + 1]);
            }
            u32x4 w; w.x = cvt_pk(y[0], y[1]); w.y = cvt_pk(y[2], y[3]); w.z = cvt_pk(y[4], y[5]); w.w = cvt_pk(y[6], y[7]);
            *(u32x4*)(Y + (size_t)row * D + 1536 + c8) = w;
        }
        }
    }
    SEAM(3);

    if (IN(4)) {
        PHASE_IDS();
        for (int id = gt; id < M * 192; id += NGT) {
            const int row = id / 192, c = id - row * 192, h = c >> 4, j = h & 3;
            const float l0 = LSE[row * 12 + j], l1 = LSE[row * 12 + 4 + j], l2 = LSE[row * 12 + 8 + j];
            const float mxl = fmaxf(l0, fmaxf(l1, l2)); const float e0 = __expf(l0 - mxl), e1 = __expf(l1 - mxl), e2 = __expf(l2 - mxl);
            const float lh = (h < 4) ? e0 : ((h < 8) ? e1 : e2); const float alpha = lh / (e0 + e1 + e2);
            const u32x4 ov = *(const u32x4*)(OA + (size_t)row * 1536 + c * 8), zv = *(const u32x4*)(PROJ + (size_t)row * NIN + ZA + c * 8);
            u32x4 w;
#pragma unroll
            for (int q = 0; q < 4; ++q) w[q] = cvt_pk(bf_lo(ov[q]) * alpha * silu_f(bf_lo(zv[q])), bf_hi(ov[q]) * alpha * silu_f(bf_hi(zv[q])));
            *(u32x4*)(Y + (size_t)row * D + c * 8) = w;
        }
    }
    SEAM(4);

    const bool fused_out = FUSED_OUT && (G == 256);
    if (IN(5)) {
        if (fused_out) { pg8::Gemm g{Y, WOUT, D, D}; pg8::PanelOrder S{bx}; pg8::EpiOut E{x, post_norm, args.out, (float*)(ws + WS_BAR) + 8192, (unsigned*)(ws + WS_BAR) + 4096};
            pg8::gemm_phase<pg8::EpiOut, pg8::PanelOrder>(lds, g, S, E); }
        else { pg8::Gemm g{Y, WOUT, D, D}; pg8::StaticOrder S; S.init(M, D, G, bx); pg8::EpiY2 E{Y2, SSQ};
            pg8::gemm_phase<pg8::EpiY2, pg8::StaticOrder>(lds, g, S, E);
            }
    }
    if (!fused_out) SEAM(5);

    if (IN(6) && !fused_out) {
        PHASE_IDS();
        float* out = args.out;
        for (int m = gw; m < M; m += NGW) {
            const float ss = wave_sum(SSQ[(size_t)m * 64 + lane]);
            const float rs = 1.0f / sqrtf(ss * (1.0f / D) + EPS);
            const f32x4* yr = (const f32x4*)(Y2 + (size_t)m * D) + lane; const f32x4* xr = (const f32x4*)(x + (size_t)m * D) + lane; const f32x4* gr = (const f32x4*)post_norm + lane;
            f32x4* orow = (f32x4*)(out + (size_t)m * D) + lane;
#pragma unroll 4
            for (int j = 0; j < 16; ++j) { const f32x4 yv = yr[64 * j], xv = xr[64 * j], gg = gr[64 * j]; orow[64 * j] = xv + yv * rs * gg; }
        }
    }
#undef PHASE_IDS
#undef IN
#undef SEAM
}

extern "C" void kernel_launch(void* const* d_in, const int* in_sizes, int n_in, void* d_out, int out_size, void* d_ws, size_t ws_size, hipStream_t stream) {
    static int grid = 0;
    if (grid == 0) {
        if (n_in != 9 || out_size != M * D || ws_size < WS_END) { fprintf(stderr, "kernel_launch: unexpected shapes (n_in %d out %d ws %zu)\n", n_in, out_size, ws_size); grid = -1; return; }
        int dev = 0, cus = 0, per_cu = 0;
        if (hipGetDevice(&dev) != hipSuccess || hipDeviceGetAttribute(&cus, hipDeviceAttributeMultiprocessorCount, dev) != hipSuccess) { grid = -1; return; }
        if (hipFuncSetAttribute((const void*)fwd, hipFuncAttributeMaxDynamicSharedMemorySize, LDS_BYTES) != hipSuccess) { fprintf(stderr, "kernel_launch: hipFuncSetAttribute failed\n"); grid = -1; return; }
        if (hipOccupancyMaxActiveBlocksPerMultiprocessor(&per_cu, (const void*)fwd, 512, LDS_BYTES) != hipSuccess || per_cu < 1) { fprintf(stderr, "kernel_launch: occupancy query says %d blocks/CU\n", per_cu); (void)hipGetLastError(); grid = -1; return; }
        grid = cus * per_cu;
    }
    if (grid < 0) return;
    if (hipMemsetAsync((char*)d_ws + WS_BAR, 0, 65536, stream) != hipSuccess) { fprintf(stderr, "kernel_launch: memset failed\n"); return; }
    Args a{};
    for (int i = 0; i < 9; ++i) a.in[i] = (const float*)d_in[i];
    a.out = (float*)d_out; a.ws = (unsigned char*)d_ws;
#if N_LAUNCH_MODE == 1
    a.ph_lo = 0; a.ph_hi = 7;
    void* kargs[] = {&a};
    hipError_t e = hipLaunchCooperativeKernel((const void*)fwd, dim3(grid), dim3(512), kargs, LDS_BYTES, stream);
    if (e != hipSuccess) fprintf(stderr, "cooperative launch failed: %s (grid %d)\n", hipGetErrorString(e), grid);
#else
    for (int ph = 0; ph < 7; ++ph) { a.ph_lo = ph; a.ph_hi = ph + 1; hipLaunchKernelGGL(fwd, dim3(grid), dim3(512), LDS_BYTES, stream, a); }
#endif
}
```
